# Optimizing an MI355X kernel written in HIP

```python
import jax, jax.numpy as jnp
from jax import lax
import numpy as np

D_MODEL = 1024
BATCH = 4
SEQ = 8192
DEPTH = 2

CHUNK = 64
Q_BLOCK = 128
EPS = 1e-6
D_FF = 4 * D_MODEL
A_HEADS = 4
A_DQK = 128
A_DV = D_MODEL // A_HEADS
B_HEADS = 8
B_NOPE = 128
B_ROPE = 64
B_VDIM = D_MODEL // B_HEADS
B_QLORA = 384
B_KVLORA = 256
ROPE_THETA = 10000.0
N_A = DEPTH // 2
N_B = DEPTH - N_A
A_PROJ = A_HEADS * (2 * A_DQK + A_DV) + D_MODEL + 2 * A_HEADS

kernel_name = "yoco_mlstm_mla_hybrid"


def rms_norm(x, g):
    xf = x.astype(jnp.float32)
    y = xf * lax.rsqrt(jnp.mean(xf * xf, axis=-1, keepdims=True) + EPS)
    return (y * g.astype(jnp.float32)).astype(x.dtype)


def modulate(h, shift, scale):
    return h * (1 + scale[:, None, :]) + shift[:, None, :]


def rope_tables(positions):
    inv = ROPE_THETA ** (-jnp.arange(0, B_ROPE, 2, dtype=jnp.float32) / B_ROPE)
    ang = positions.astype(jnp.float32)[..., None] * inv
    return jnp.cos(ang), jnp.sin(ang)


def apply_rope(x, cos, sin):
    x1, x2 = jnp.split(x.astype(jnp.float32), 2, axis=-1)
    out = jnp.concatenate([x1 * cos - x2 * sin, x1 * sin + x2 * cos], axis=-1)
    return out.astype(x.dtype)


def sq_relu_mlp(h, w1, w2):
    return jnp.square(jax.nn.relu(h @ w1)) @ w2


def mlstm_chunkwise(q, k, v, i_pre, f_pre):
    Bn, S, H, dk = q.shape
    dv = v.shape[-1]
    nc = S // CHUNK
    f32 = jnp.float32

    def chunks(t):
        return t.astype(f32).reshape(Bn, nc, CHUNK, H, t.shape[-1]).transpose(1, 0, 3, 2, 4)

    def gchunks(t):
        return t.astype(f32).reshape(Bn, nc, CHUNK, H).transpose(1, 0, 3, 2)

    qc = chunks(q) * (dk ** -0.5)
    kc, vc = chunks(k), chunks(v)
    ic = gchunks(i_pre)
    bc = jnp.cumsum(jax.nn.log_sigmoid(gchunks(f_pre)), axis=-1)
    causal = jnp.tril(jnp.ones((CHUNK, CHUNK), dtype=bool))

    def step(carry, xs):
        C, n, m = carry
        qj, kj, vj, ij, bj = xs
        D = bj[..., :, None] - bj[..., None, :] + ij[..., None, :]
        D = jnp.where(causal, D, -jnp.inf)
        inter = bj + m[..., None]
        m_t = jnp.maximum(inter, jnp.max(D, axis=-1))
        w_inter = jnp.exp(inter - m_t)
        P = jnp.exp(D - m_t[..., None]) * jnp.einsum('bhld,bhsd->bhls', qj, kj)
        num = w_inter[..., None] * jnp.einsum('bhld,bhde->bhle', qj, C) + jnp.einsum('bhls,bhse->bhle', P, vj)
        den = w_inter * jnp.einsum('bhld,bhd->bhl', qj, n) + jnp.sum(P, axis=-1)
        h = num / jnp.maximum(jnp.abs(den), jnp.exp(-m_t))[..., None]
        b_last = bj[..., -1]
        g = b_last[..., None] - bj + ij
        m_new = jnp.maximum(b_last + m, jnp.max(g, axis=-1))
        decay = jnp.exp(b_last + m - m_new)
        wk = jnp.exp(g - m_new[..., None])
        C = decay[..., None, None] * C + jnp.einsum('bhs,bhsd,bhse->bhde', wk, kj, vj)
        n = decay[..., None] * n + jnp.einsum('bhs,bhsd->bhd', wk, kj)
        return (C, n, m_new), h

    init = (jnp.zeros((Bn, H, dk, dv), f32), jnp.zeros((Bn, H, dk), f32), jnp.zeros((Bn, H), f32))
    _, hs = lax.scan(step, init, (qc, kc, vc, ic, bc))
    return hs.transpose(1, 0, 3, 2, 4).reshape(Bn, S, H, dv).astype(q.dtype)


def mlstm_mixer(h, w_in, b_gates, head_norm, w_out):
    Bn, S, _ = h.shape
    sizes = [A_HEADS * A_DQK, A_HEADS * A_DQK, A_HEADS * A_DV, D_MODEL, A_HEADS, A_HEADS]
    idx = [int(s) for s in np.cumsum(sizes)[:-1]]
    q, k, v, o_pre, i_pre, f_pre = jnp.split(h @ w_in, idx, axis=-1)
    q = q.reshape(Bn, S, A_HEADS, A_DQK)
    k = k.reshape(Bn, S, A_HEADS, A_DQK)
    v = v.reshape(Bn, S, A_HEADS, A_DV)
    i_pre = i_pre + b_gates[:A_HEADS]
    f_pre = f_pre + b_gates[A_HEADS:]
    hh = mlstm_chunkwise(q, k, v, i_pre, f_pre)
    hh = rms_norm(hh, head_norm).reshape(Bn, S, D_MODEL)
    return (jax.nn.sigmoid(o_pre) * hh) @ w_out


def mla_shared_kv(x, c_act, kv_mod_w, kv_mod_b, kv_norm, w_dkv, kv_lora_norm, w_ukv, cos, sin):
    Bn, S, _ = x.shape
    shift, scale = jnp.split(c_act @ kv_mod_w + kv_mod_b, 2, axis=-1)
    hs = modulate(rms_norm(x, kv_norm), shift, scale)
    ckv, k_rope = jnp.split(hs @ w_dkv, [B_KVLORA], axis=-1)
    ckv = rms_norm(ckv, kv_lora_norm)
    kv = (ckv @ w_ukv).reshape(Bn, S, B_HEADS, B_NOPE + B_VDIM)
    k_nope, v = jnp.split(kv, [B_NOPE], axis=-1)
    k_rope = apply_rope(k_rope, cos, sin)
    return k_nope, k_rope, v


def mla_attention(q_nope, q_rope, k_nope, k_rope, v):
    Bn, S = q_nope.shape[:2]
    nb = S // Q_BLOCK
    scale = (B_NOPE + B_ROPE) ** -0.5
    key_chunk = jnp.arange(S) // CHUNK
    qn_b = q_nope.reshape(Bn, nb, Q_BLOCK, B_HEADS, B_NOPE).transpose(1, 0, 2, 3, 4)
    qr_b = q_rope.reshape(Bn, nb, Q_BLOCK, B_HEADS, B_ROPE).transpose(1, 0, 2, 3, 4)

    def block(args):
        qn, qr, blk = args
        s = jnp.einsum('bqhd,bkhd->bhqk', qn, k_nope) + jnp.einsum('bqhd,bkd->bhqk', qr, k_rope)
        s = s.astype(jnp.float32) * scale
        q_chunk = (blk * Q_BLOCK + jnp.arange(Q_BLOCK)) // CHUNK
        mask = key_chunk[None, :] <= q_chunk[:, None]
        p = jax.nn.softmax(jnp.where(mask, s, -jnp.inf), axis=-1).astype(v.dtype)
        return jnp.einsum('bhqk,bkhd->bqhd', p, v)

    out = lax.map(block, (qn_b, qr_b, jnp.arange(nb)))
    return out.transpose(1, 0, 2, 3, 4).reshape(Bn, S, B_HEADS * B_VDIM)


def mla_mixer(h, w_qa, q_norm, w_qb, w_o, k_nope, k_rope, v, cos, sin):
    Bn, S, _ = h.shape
    q = (rms_norm(h @ w_qa, q_norm) @ w_qb).reshape(Bn, S, B_HEADS, B_NOPE + B_ROPE)
    q_nope, q_rope = jnp.split(q, [B_NOPE], axis=-1)
    q_rope = apply_rope(q_rope, cos[:, :, None, :], sin[:, :, None, :])
    return mla_attention(q_nope, q_rope, k_nope, k_rope, v) @ w_o


def setup_inputs(seed: int = 0) -> dict:
    key = jax.random.key(seed)
    ks = jax.random.split(key, 24)
    nrm = lambda k, shape, fan: jax.random.normal(k, shape, jnp.float32) * fan ** -0.5
    x = jax.random.normal(ks[0], (BATCH, SEQ, D_MODEL), jnp.float32)
    c = jax.random.normal(ks[1], (BATCH, D_MODEL), jnp.float32)
    offsets = jax.random.randint(ks[2], (BATCH, 1), 0, 64) * CHUNK
    positions = (offsets + jnp.arange(SEQ, dtype=jnp.int32)[None, :]).astype(jnp.int32)
    mod_w = nrm(ks[3], (DEPTH, D_MODEL, 6 * D_MODEL), D_MODEL) * 0.5
    mod_b = 0.01 * jax.random.normal(ks[4], (DEPTH, 6 * D_MODEL), jnp.float32)
    norm_g = 1.0 + 0.02 * jax.random.normal(ks[5], (DEPTH, 4, D_MODEL), jnp.float32)
    ffn_w1 = nrm(ks[6], (DEPTH, D_MODEL, D_FF), D_MODEL)
    ffn_w2 = nrm(ks[7], (DEPTH, D_FF, D_MODEL), D_FF)
    a_w_in = nrm(ks[8], (N_A, D_MODEL, A_PROJ), D_MODEL)
    i_bias = 0.1 * jax.random.normal(ks[9], (N_A, A_HEADS), jnp.float32)
    f_bias = jnp.linspace(3.0, 6.0, A_HEADS, dtype=jnp.float32)[None, :] + 0.1 * jax.random.normal(ks[10], (N_A, A_HEADS), jnp.float32)
    a_b_gates = jnp.concatenate([i_bias, f_bias], axis=-1)
    a_head_norm = 1.0 + 0.02 * jax.random.normal(ks[11], (N_A, A_HEADS, A_DV), jnp.float32)
    a_w_out = nrm(ks[12], (N_A, D_MODEL, D_MODEL), D_MODEL)
    b_w_qa = nrm(ks[13], (N_B, D_MODEL, B_QLORA), D_MODEL)
    b_q_norm = 1.0 + 0.02 * jax.random.normal(ks[14], (N_B, B_QLORA), jnp.float32)
    b_w_qb = nrm(ks[15], (N_B, B_QLORA, B_HEADS * (B_NOPE + B_ROPE)), B_QLORA)
    b_w_o = nrm(ks[16], (N_B, B_HEADS * B_VDIM, D_MODEL), B_HEADS * B_VDIM)
    kv_mod_w = nrm(ks[17], (D_MODEL, 2 * D_MODEL), D_MODEL) * 0.5
    kv_mod_b = 0.01 * jax.random.normal(ks[18], (2 * D_MODEL,), jnp.float32)
    kv_norm = 1.0 + 0.02 * jax.random.normal(ks[19], (D_MODEL,), jnp.float32)
    w_dkv = nrm(ks[20], (D_MODEL, B_KVLORA + B_ROPE), D_MODEL)
    kv_lora_norm = 1.0 + 0.02 * jax.random.normal(ks[21], (B_KVLORA,), jnp.float32)
    w_ukv = nrm(ks[22], (B_KVLORA, B_HEADS * (B_NOPE + B_VDIM)), B_KVLORA)
    return {"x": x, "c": c, "positions": positions, "mod_w": mod_w, "mod_b": mod_b, "norm_g": norm_g,
            "ffn_w1": ffn_w1, "ffn_w2": ffn_w2, "a_w_in": a_w_in, "a_b_gates": a_b_gates,
            "a_head_norm": a_head_norm, "a_w_out": a_w_out, "b_w_qa": b_w_qa, "b_q_norm": b_q_norm,
            "b_w_qb": b_w_qb, "b_w_o": b_w_o, "kv_mod_w": kv_mod_w, "kv_mod_b": kv_mod_b,
            "kv_norm": kv_norm, "w_dkv": w_dkv, "kv_lora_norm": kv_lora_norm, "w_ukv": w_ukv}


def reference(x, c, positions, mod_w, mod_b, norm_g, ffn_w1, ffn_w2, a_w_in, a_b_gates, a_head_norm,
              a_w_out, b_w_qa, b_q_norm, b_w_qb, b_w_o, kv_mod_w, kv_mod_b, kv_norm, w_dkv,
              kv_lora_norm, w_ukv):
    cos, sin = rope_tables(positions)
    c_act = jax.nn.silu(c)
    k_nope = k_rope = v = None
    for layer in range(DEPTH):
        sh1, sc1, g1, sh2, sc2, g2 = jnp.split(c_act @ mod_w[layer] + mod_b[layer], 6, axis=-1)
        h = modulate(rms_norm(x, norm_g[layer, 0]), sh1, sc1)
        if layer < N_A:
            y = mlstm_mixer(h, a_w_in[layer], a_b_gates[layer], a_head_norm[layer], a_w_out[layer])
        else:
            if layer == N_A:
                k_nope, k_rope, v = mla_shared_kv(x, c_act, kv_mod_w, kv_mod_b, kv_norm, w_dkv,
                                                  kv_lora_norm, w_ukv, cos, sin)
            j = layer - N_A
            y = mla_mixer(h, b_w_qa[j], b_q_norm[j], b_w_qb[j], b_w_o[j], k_nope, k_rope, v, cos, sin)
        x = x + g1[:, None, :] * rms_norm(y, norm_g[layer, 1])
        h = modulate(rms_norm(x, norm_g[layer, 2]), sh2, sc2)
        y = sq_relu_mlp(h, ffn_w1[layer], ffn_w2[layer])
        x = x + g2[:, None, :] * rms_norm(y, norm_g[layer, 3])
    return x
```

```cpp
#include <hip/hip_runtime.h>
#include <hip/hip_bf16.h>
#include <cmath>
#include <cstdio>
#include <cstdint>
namespace pg8 {
#define PG8_LAS __attribute__((address_space(3)))
typedef unsigned short bf16_t;
typedef short bf16x8 __attribute__((ext_vector_type(8)));
typedef float f32x4 __attribute__((ext_vector_type(4)));
typedef unsigned u32x4 __attribute__((ext_vector_type(4)));
constexpr int BM = 256, BK = 64, HALF = 128, HTB = HALF * BK * 2  , STAGE_BYTES = 8 * HTB, NXCD = 8, WGM = 8;

__host__ __device__ __forceinline__ int lds_byte(int r, int c) { const int st = (r >> 4) * 2 + (c >> 5), rr = r & 15, cc = c & 31, ob = rr * 64 + cc * 2; return st * 1024 + (ob ^ (((ob >> 9) & 1) << 5)); }
__host__ __device__ __forceinline__ void stage_rc(int b, int& R, int& C) { const int st = b / 1024, sb = b % 1024, swz = sb ^ (((sb >> 9) & 1) << 5); R = (st >> 1) * 16 + swz / 64; C = (st & 1) * 32 + (swz % 64) / 2; }
__host__ __device__ __forceinline__ int perm32(int rho) { const int n = rho >> 4, i = rho & 15; return 8 * (i >> 2) + 4 * n + (i & 3); }

struct Unit { int pm, pn; };
struct Gemm { const bf16_t* A; const bf16_t* Bt; int M, N, K; };

struct StaticOrder {
    int nM, nN, nwg, G, c;
    __host__ __device__ void init(int M, int N, int G_, int c_) { nM = M / BM; nN = N / BM; nwg = nM * nN; G = G_; c = c_; }
    __host__ __device__ bool next(int i, Unit& u) const {
        const long L = (long)i * G + c; if (L >= nwg) return false;
        int wgid = (int)L; { const int q = nwg / NXCD, r = nwg % NXCD, xcd = wgid % NXCD, off = wgid / NXCD; wgid = (xcd < r ? xcd * (q + 1) : r * (q + 1) + (xcd - r) * q) + off; }
        const int nig = WGM * nN, gid = wgid / nig, fm = gid * WGM, gsz = (nM - fm) < WGM ? (nM - fm) : WGM;
        u.pm = fm + ((wgid % nig) % gsz); u.pn = (wgid % nig) / gsz; return true;
    }
    __device__ __forceinline__ void a_ready(const Unit&) const {}
    __device__ __forceinline__ void done(const Unit&) const {}
};

__device__ __forceinline__ unsigned cvt_pk_bf16(float lo, float hi) { unsigned r; asm volatile("v_cvt_pk_bf16_f32 %0, %1, %2" : "=v"(r) : "v"(lo), "v"(hi)); return r; }
typedef float f32x2 __attribute__((ext_vector_type(2)));
__device__ __forceinline__ f32x2 gelu_pk(f32x2 v) {
    const f32x2 av = __builtin_elementwise_abs(v), d = av * 0.2316418882f + 1.0f;
    f32x2 t; t.x = __builtin_amdgcn_rcpf(d.x); t.y = __builtin_amdgcn_rcpf(d.y);
    f32x2 q = t * 0.5307027145f + (-0.7265760135f); q = q * t + 0.7107068705f; q = q * t + (-0.142248368f); q = q * t + 0.127414796f; q = q * t;
    const f32x2 s = (v * v) * (-0.72134752044f);
    f32x2 e; e.x = __builtin_amdgcn_exp2f(s.x); e.y = __builtin_amdgcn_exp2f(s.y);
    const f32x2 m = v * (q * e), r = v - m;
    f32x2 o; o.x = v.x < 0.f ? m.x : r.x; o.y = v.y < 0.f ? m.y : r.y; return o;
}

template <int ACT  > struct EpiBf16 {
    static constexpr bool PERM = true, AFTER_DRAIN = false; static_assert(ACT == 0 || ACT == 1 || ACT == 2, "EpiBf16: ACT is 0 (none), 1 (gelu_pk) or 2 (squared relu)");
    bf16_t* O; int ldc; const float* bias; int split_cols; size_t split_stride; float scale0;
    __device__ __forceinline__ void operator()(const f32x4 (&acc)[2][2][4][2], const Unit& u, int wr, int wc, int fr, int fq) const {
        const int row0 = u.pm * BM + wr * 64 + fr; int colt = u.pn * BM; bf16_t* base = O;
        float sc = 1.f; if (split_cols) { const int t = colt / split_cols; base += (size_t)t * split_stride; colt -= t * split_cols; if (t == 0) sc = scale0; }
        const int col0 = colt + wc * 32 + 8 * fq, bcol0 = u.pn * BM + wc * 32 + 8 * fq;
        f32x4 bv[2][2];
#pragma unroll
        for (int bj = 0; bj < 2; ++bj)
#pragma unroll
            for (int n = 0; n < 2; ++n) bv[bj][n] = bias ? *(const f32x4*)(bias + bcol0 + bj * HALF + 4 * n) : (f32x4){0.f, 0.f, 0.f, 0.f};
#pragma unroll
        for (int ai = 0; ai < 2; ++ai)
#pragma unroll
            for (int m = 0; m < 4; ++m) { bf16_t* rowp = base + (size_t)(row0 + ai * HALF + m * 16) * ldc + col0;
#pragma unroll
                for (int bj = 0; bj < 2; ++bj) { f32x4 v0 = acc[ai][bj][m][0] + bv[bj][0], v1 = acc[ai][bj][m][1] + bv[bj][1];
                    if (ACT == 1) { f32x2 a = gelu_pk((f32x2){v0[0], v0[1]}), b = gelu_pk((f32x2){v0[2], v0[3]}), c = gelu_pk((f32x2){v1[0], v1[1]}), d = gelu_pk((f32x2){v1[2], v1[3]});
                        v0 = (f32x4){a.x, a.y, b.x, b.y}; v1 = (f32x4){c.x, c.y, d.x, d.y}; }
                    if (ACT == 2) { const f32x4 z = {0.f, 0.f, 0.f, 0.f}; v0 = __builtin_elementwise_max(v0, z); v1 = __builtin_elementwise_max(v1, z); v0 = v0 * v0; v1 = v1 * v1; }
                    v0 = v0 * sc; v1 = v1 * sc; u32x4 w; w.x = cvt_pk_bf16(v0[0], v0[1]); w.y = cvt_pk_bf16(v0[2], v0[3]); w.z = cvt_pk_bf16(v1[0], v1[1]); w.w = cvt_pk_bf16(v1[2], v1[3]);
                    *(u32x4*)(rowp + bj * HALF) = w; } }
    }
};

template <class Epi, class Sched, bool ALIGN_EPI = false, bool SP2 = false>
__device__ __forceinline__ void gemm_phase(PG8_LAS unsigned char* lds, const Gemm g, const Sched& S, const Epi& E) {
    const int tid = threadIdx.x, wid = __builtin_amdgcn_readfirstlane(tid >> 6), lane = tid & 63, wr = wid >> 2, wc = wid & 3, fr = lane & 15, fq = lane >> 4;
    const int K = g.K, nt = K / BK;
    unsigned voffA[2], voffB[2];
#pragma unroll
    for (int i = 0; i < 2; ++i) { int R, C; stage_rc(tid * 16 + i * 8192, R, C); const int Rb = Epi::PERM ? ((R & ~31) + perm32(R & 31)) : R;
        voffA[i] = (unsigned)(R * K + C) * 2u; voffB[i] = (unsigned)(Rb * K + C) * 2u; }
    const size_t kstep = (size_t)(BK * 2);
    const size_t hstep = (size_t)HALF * K * 2;
    const size_t tstep = 2 * hstep;
    const unsigned ldsw = (unsigned)wid * 1024u;
    const int aoff = lds_byte(wr * 64 + fr, fq * 8), boff = lds_byte(wc * 32 + fr, fq * 8);
#define PG8_SA(b, h) (((b) * 2 + (h)) * HTB)
#define PG8_SB(b, h) ((4 + (b) * 2 + (h)) * HTB)
#define PG8_STAGE(bufoff, gbase, voff) do { _Pragma("unroll") for (int _i = 0; _i < 2; ++_i) \
        __builtin_amdgcn_global_load_lds((const unsigned*)((const char*)(gbase) + (voff)[_i]), (PG8_LAS unsigned*)(lds + (bufoff) + ldsw + _i * 8192), 16, 0, 0); } while (0)
#define PG8_LDA(dst, b, h) do { _Pragma("unroll") for (int m = 0; m < 4; ++m) _Pragma("unroll") for (int k = 0; k < 2; ++k) dst[m][k] = *(const PG8_LAS bf16x8*)(lds + PG8_SA(b, h) + aoff + m * 2048 + k * 1024); } while (0)
#define PG8_LDB(dst, b, h) do { _Pragma("unroll") for (int n = 0; n < 2; ++n) _Pragma("unroll") for (int k = 0; k < 2; ++k) dst[n][k] = *(const PG8_LAS bf16x8*)(lds + PG8_SB(b, h) + boff + n * 2048 + k * 1024); } while (0)
#define PG8_MMA(ai, bj, At, Bt) do { __builtin_amdgcn_s_setprio(1); _Pragma("unroll") for (int m = 0; m < 4; ++m) _Pragma("unroll") for (int n = 0; n < 2; ++n) _Pragma("unroll") for (int k = 0; k < 2; ++k) \
        acc[ai][bj][m][n] = __builtin_amdgcn_mfma_f32_16x16x32_bf16(Bt[n][k], At[m][k], acc[ai][bj][m][n], 0, 0, 0); __builtin_amdgcn_s_setprio(0); } while (0)
#define PG8_WAIT_V(n) asm volatile("s_waitcnt vmcnt(" #n ")" ::: "memory")
#define PG8_WAIT_L(n) asm volatile("s_waitcnt lgkmcnt(" #n ")" ::: "memory")
#define PG8_BAR __builtin_amdgcn_s_barrier()
#define PG8_SCHED __builtin_amdgcn_sched_barrier(0)
    Unit cur, nxt; int ui = 0;
    if (!S.next(0, cur)) return;
    f32x4 acc[2][2][4][2];
#pragma unroll
    for (int a = 0; a < 2; ++a)
#pragma unroll
        for (int b = 0; b < 2; ++b)
#pragma unroll
            for (int m = 0; m < 4; ++m)
#pragma unroll
                for (int n = 0; n < 2; ++n) acc[a][b][m][n] = (f32x4){0.f, 0.f, 0.f, 0.f};
    bf16x8 At[4][2], B0[2][2], B1[2][2];
    const char* cA = (const char*)g.A + (size_t)cur.pm * tstep; const char* cB = (const char*)g.Bt + (size_t)cur.pn * tstep;
    S.a_ready(cur);
    if constexpr (SP2) {
        PG8_STAGE(PG8_SB(0, 0), cB, voffB); PG8_STAGE(PG8_SB(0, 1), cB + hstep, voffB); PG8_STAGE(PG8_SA(0, 0), cA, voffA); PG8_STAGE(PG8_SA(0, 1), cA + hstep, voffA);
        if (wr == 1) PG8_BAR;
        PG8_WAIT_V(2); PG8_BAR;
        PG8_STAGE(PG8_SB(1, 0), cB + kstep, voffB); PG8_STAGE(PG8_SA(1, 0), cA + kstep, voffA); PG8_STAGE(PG8_SB(1, 1), cB + hstep + kstep, voffB);
        PG8_WAIT_V(6); PG8_BAR;
    } else {
        PG8_STAGE(PG8_SB(0, 0), cB, voffB); PG8_STAGE(PG8_SA(0, 0), cA, voffA); PG8_STAGE(PG8_SB(0, 1), cB + hstep, voffB); PG8_STAGE(PG8_SA(0, 1), cA + hstep, voffA);
        if (wr == 1) PG8_BAR;
        PG8_WAIT_V(4); PG8_BAR;
        PG8_STAGE(PG8_SB(1, 0), cB + kstep, voffB); PG8_STAGE(PG8_SA(1, 0), cA + kstep, voffA); PG8_STAGE(PG8_SB(1, 1), cB + hstep + kstep, voffB);
        PG8_WAIT_V(6); PG8_BAR;
    }
    for (;;) {
        const bool has_next = S.next(ui + 1, nxt);
        const char* nA = has_next ? (const char*)g.A + (size_t)nxt.pm * tstep : cA; const char* nB = has_next ? (const char*)g.Bt + (size_t)nxt.pn * tstep : cB;
        for (int t = 0; t < nt; t += 2) {
            const bool last = (t == nt - 2);
            const char* a1 = cA + (size_t)(t + 1) * kstep;
            const char* a2 = last ? nA : cA + (size_t)(t + 2) * kstep; const char* b2 = last ? nB : cB + (size_t)(t + 2) * kstep;
            const char* a3 = a2 + kstep; const char* b3 = b2 + kstep;
            if (last && has_next) S.a_ready(nxt);
            if constexpr (SP2) {
            PG8_LDB(B0, 0, 0); PG8_LDB(B1, 0, 1); PG8_SCHED; PG8_LDA(At, 0, 0); PG8_STAGE(PG8_SA(1, 1), a1 + hstep, voffA);
            PG8_WAIT_V(8); PG8_WAIT_L(0); PG8_BAR; PG8_MMA(0, 0, At, B0); PG8_MMA(0, 1, At, B1); PG8_BAR; PG8_SCHED;
            PG8_LDA(At, 0, 1); PG8_STAGE(PG8_SB(0, 0), b2, voffB); PG8_STAGE(PG8_SB(0, 1), b2 + hstep, voffB); PG8_STAGE(PG8_SA(0, 0), a2, voffA);
            PG8_WAIT_V(8); PG8_WAIT_L(0); PG8_BAR; PG8_MMA(1, 0, At, B0); PG8_MMA(1, 1, At, B1); PG8_BAR; PG8_SCHED;
            PG8_LDB(B0, 1, 0); PG8_LDB(B1, 1, 1); PG8_SCHED; PG8_LDA(At, 1, 0); PG8_STAGE(PG8_SA(0, 1), a2 + hstep, voffA);
            PG8_WAIT_V(8); PG8_WAIT_L(0); PG8_BAR; PG8_MMA(0, 0, At, B0); PG8_MMA(0, 1, At, B1); PG8_BAR; PG8_SCHED;
            PG8_LDA(At, 1, 1); PG8_STAGE(PG8_SB(1, 0), b3, voffB); PG8_STAGE(PG8_SB(1, 1), b3 + hstep, voffB); PG8_STAGE(PG8_SA(1, 0), a3, voffA);
            PG8_WAIT_V(8); PG8_WAIT_L(0); PG8_BAR; PG8_MMA(1, 0, At, B0); PG8_MMA(1, 1, At, B1); PG8_BAR; PG8_SCHED;
            } else {
            PG8_LDB(B0, 0, 0); PG8_SCHED; PG8_LDA(At, 0, 0); PG8_STAGE(PG8_SA(1, 1), a1 + hstep, voffA);
            PG8_WAIT_L(8); PG8_BAR; PG8_WAIT_L(0); PG8_MMA(0, 0, At, B0); PG8_BAR; PG8_SCHED;
            PG8_LDB(B1, 0, 1); PG8_STAGE(PG8_SB(0, 0), b2, voffB);
            PG8_BAR; PG8_WAIT_L(0); PG8_MMA(0, 1, At, B1); PG8_BAR;
            PG8_LDA(At, 0, 1); PG8_STAGE(PG8_SA(0, 0), a2, voffA);
            PG8_BAR; PG8_WAIT_L(0); PG8_MMA(1, 0, At, B0); PG8_BAR; PG8_SCHED;
            PG8_STAGE(PG8_SB(0, 1), b2 + hstep, voffB);
            PG8_WAIT_V(6); PG8_BAR; PG8_MMA(1, 1, At, B1); PG8_BAR;
            PG8_LDB(B0, 1, 0); PG8_SCHED; PG8_LDA(At, 1, 0); PG8_STAGE(PG8_SA(0, 1), a2 + hstep, voffA);
            PG8_WAIT_L(8); PG8_BAR; PG8_WAIT_L(0); PG8_MMA(0, 0, At, B0); PG8_BAR; PG8_SCHED;
            PG8_LDB(B1, 1, 1); PG8_STAGE(PG8_SB(1, 0), b3, voffB);
            PG8_BAR; PG8_WAIT_L(0); PG8_MMA(0, 1, At, B1); PG8_BAR;
            PG8_LDA(At, 1, 1); PG8_STAGE(PG8_SA(1, 0), a3, voffA);
            PG8_BAR; PG8_WAIT_L(0); PG8_MMA(1, 0, At, B0); PG8_BAR; PG8_SCHED;
            PG8_STAGE(PG8_SB(1, 1), b3 + hstep, voffB);
            PG8_WAIT_V(6); PG8_BAR; PG8_MMA(1, 1, At, B1); PG8_BAR;
            }
        }
        if constexpr (ALIGN_EPI) { if (wr == 0) PG8_BAR; }
        if constexpr (!Epi::AFTER_DRAIN) { E(acc, cur, wr, wc, fr, fq); S.done(cur); }
        if (!has_next) break;
#pragma unroll
        for (int a = 0; a < 2; ++a)
#pragma unroll
            for (int b = 0; b < 2; ++b)
#pragma unroll
                for (int m = 0; m < 4; ++m)
#pragma unroll
                    for (int n = 0; n < 2; ++n) acc[a][b][m][n] = (f32x4){0.f, 0.f, 0.f, 0.f};
        cur = nxt; cA = nA; cB = nB; ++ui;
        if constexpr (ALIGN_EPI) { if (wr == 1) PG8_BAR; }
    }
    PG8_WAIT_V(0);
    if constexpr (!ALIGN_EPI) { if (wr == 0) PG8_BAR; }
    PG8_BAR;
    if constexpr (Epi::AFTER_DRAIN) { E.fused(acc, cur, wr, wc, fr, fq, lds, wid, lane); S.done(cur); }
#undef PG8_SA
#undef PG8_SB
#undef PG8_STAGE
#undef PG8_LDA
#undef PG8_LDB
#undef PG8_MMA
#undef PG8_WAIT_V
#undef PG8_WAIT_L
#undef PG8_BAR
#undef PG8_SCHED
}
}


#include <hip/hip_cooperative_groups.h>
namespace cg = cooperative_groups;
namespace mk {
#define LAS __attribute__((address_space(3)))
typedef unsigned short bf16_t;
typedef short s16x8 __attribute__((ext_vector_type(8)));
typedef short s16x4 __attribute__((ext_vector_type(4)));
typedef float f32x4 __attribute__((ext_vector_type(4)));
typedef float f32x2 __attribute__((ext_vector_type(2)));
typedef float f32x16 __attribute__((ext_vector_type(16)));
typedef unsigned u32x4 __attribute__((ext_vector_type(4)));
typedef unsigned u32x2 __attribute__((ext_vector_type(2)));
typedef __bf16 bf16x2_t __attribute__((ext_vector_type(2)));

constexpr int NB = 4, SEQ = 8192, DM = 1024, M = NB * SEQ, DFF = 4096;
constexpr int APN = 3072, APROJ = 3080;
constexpr float EPS = 1e-6f;
constexpr size_t MiB = 1u << 20;
constexpr size_t WS_MODS = 1 * MiB, WS_GATES = 2 * MiB, WS_BCUM = 3 * MiB, WS_WINT = 3 * MiB + 512 * 1024, WS_ENEG = 4 * MiB, WS_DENI = 4 * MiB + 512 * 1024, WS_DEN = 5 * MiB,
                 WS_CHS = 5 * MiB + 512 * 1024;
constexpr size_t WS_WIN = 8 * MiB, WS_WOUT = 14 * MiB, WS_W1A = 16 * MiB, WS_W2A = 24 * MiB, WS_W1B = 32 * MiB, WS_W2B = 40 * MiB, WS_WQA = 48 * MiB, WS_WDKV = 49 * MiB,
                 WS_WQB = 50 * MiB, WS_WUKV = 52 * MiB, WS_WO = 53 * MiB, WS_ROPE = 56 * MiB;
constexpr size_t WS_HN = 64 * MiB, WS_Y = 128 * MiB, WS_KWT = 128 * MiB, WS_PROJ = 192 * MiB, WS_VT = 384 * MiB, WS_H1 = 192 * MiB;
constexpr size_t WS_HNKV = 192 * MiB, WS_CKV = 256 * MiB, WS_QA = 288 * MiB, WS_CKVN = 320 * MiB, WS_QAN = 336 * MiB, WS_KR = 360 * MiB, WS_KV = 364 * MiB, WS_Q = 192 * MiB;
constexpr size_t WS_XB = 448 * MiB;
constexpr size_t WS_END = 512 * MiB;
constexpr int LDS_BYTES = 147456;

__device__ __forceinline__ unsigned cvtpk(float lo, float hi) { f32x2 v = {lo, hi}; bf16x2_t b = __builtin_convertvector(v, bf16x2_t); return __builtin_bit_cast(unsigned, b); }
__device__ __forceinline__ float bflo(unsigned u) { return __uint_as_float(u << 16); }
__device__ __forceinline__ float bfhi(unsigned u) { return __uint_as_float(u & 0xffff0000u); }
__device__ __forceinline__ float bf1(unsigned short h) { return __uint_as_float((unsigned)h << 16); }
__device__ __forceinline__ s16x8 pack8(f32x4 a, f32x4 b) { u32x4 w; w.x = cvtpk(a[0], a[1]); w.y = cvtpk(a[2], a[3]); w.z = cvtpk(b[0], b[1]); w.w = cvtpk(b[2], b[3]); return __builtin_bit_cast(s16x8, w); }
__device__ __forceinline__ s16x8 cat4(s16x4 a, s16x4 b) { return __builtin_shufflevector(a, b, 0, 1, 2, 3, 4, 5, 6, 7); }
#define MK_DPP_ADD(v, ctrl) ((v) + __uint_as_float((unsigned)__builtin_amdgcn_update_dpp(0, (int)__float_as_uint(v), (ctrl), 0xF, 0xF, true)))
__device__ __forceinline__ float wave_sum(float v) {
    v = MK_DPP_ADD(v, 0xB1); v = MK_DPP_ADD(v, 0x4E); v = MK_DPP_ADD(v, 0x141); v = MK_DPP_ADD(v, 0x140);
    v += __shfl_xor(v, 16);
    const auto rr = __builtin_amdgcn_permlane32_swap(__float_as_uint(v), __float_as_uint(v), false, false);
    return __uint_as_float(rr[0]) + __uint_as_float(rr[1]);
}
#define MK_DPP_F(v, ctrl) __uint_as_float((unsigned)__builtin_amdgcn_update_dpp(0, (int)__float_as_uint(v), (ctrl), 0xF, 0xF, true))
__device__ __forceinline__ float wave_max(float v) {
    v = fmaxf(v, MK_DPP_F(v, 0xB1)); v = fmaxf(v, MK_DPP_F(v, 0x4E)); v = fmaxf(v, MK_DPP_F(v, 0x141)); v = fmaxf(v, MK_DPP_F(v, 0x140));
    v = fmaxf(v, __shfl_xor(v, 16));
    const auto rr = __builtin_amdgcn_permlane32_swap(__float_as_uint(v), __float_as_uint(v), false, false);
    return fmaxf(__uint_as_float(rr[0]), __uint_as_float(rr[1]));
}
#define MFMA16(a, b, c) __builtin_amdgcn_mfma_f32_16x16x32_bf16((a), (b), (c), 0, 0, 0)
#define MFMA32(a, b, c) __builtin_amdgcn_mfma_f32_32x32x16_bf16((a), (b), (c), 0, 0, 0)

struct Args { const float* in[22]; float* out; unsigned char* ws; };
struct Ctx {
    LAS unsigned char* lds; unsigned char* ws; int tid, lane, wave, G;
};
__device__ __forceinline__ Ctx mkctx(unsigned char* lds_raw, unsigned char* ws) {
    Ctx c; int t = threadIdx.x; asm volatile("" : "+v"(t)); c.tid = t; c.lane = t & 63; c.wave = __builtin_amdgcn_readfirstlane(t >> 6); c.lds = (LAS unsigned char*)lds_raw; c.ws = ws; c.G = gridDim.x; return c; }

__device__ __forceinline__ void p0_transpose_item(const float* W, int ldw, int ncols, int K, bf16_t* WT, LAS float* scr, int item, int lane) {
    const int nblk = ncols / 32, kb = item / nblk, nb = item % nblk, k0 = 64 * kb, n0 = 32 * nb;
#pragma unroll 8
    for (int i = 0; i < 32; ++i) { const int kk = 2 * i + (lane >> 5); scr[kk * 33 + (lane & 31)] = W[(size_t)(k0 + kk) * ldw + n0 + (lane & 31)]; }
    asm volatile("s_waitcnt lgkmcnt(0)" ::: "memory");
    const int c = lane & 7;
#pragma unroll
    for (int j = 0; j < 4; ++j) { const int n = (lane >> 3) + 8 * j; const LAS float* s = scr + (8 * c) * 33 + n;
        u32x4 o; o.x = cvtpk(s[0 * 33], s[1 * 33]); o.y = cvtpk(s[2 * 33], s[3 * 33]); o.z = cvtpk(s[4 * 33], s[5 * 33]); o.w = cvtpk(s[6 * 33], s[7 * 33]);
        *(u32x4*)(WT + (size_t)(n0 + n) * K + k0 + 8 * c) = o; }
    asm volatile("s_waitcnt lgkmcnt(0)" ::: "memory");
}

__device__ __forceinline__ void p0_weights(const Ctx& c, const Args& a, int part, int bidx, int nblk) {
    unsigned char* ws = c.ws;
    LAS float* scr = (LAS float*)(c.lds + c.wave * 8704);
    const int gw = bidx * 8 + c.wave, NGW = nblk * 8;
    constexpr int I_IN = 16 * 96, I_OUT = 16 * 32, I_W1 = 16 * 128, I_W2 = 64 * 32, I_QA = 16 * 12, I_DKV = 16 * 10, I_QB = 6 * 48, I_UKV = 4 * 64, I_O = 16 * 32;
    if (part == 0) {
        for (int it = gw; it < I_IN; it += NGW) p0_transpose_item(a.in[8], APROJ, APN, 1024, (bf16_t*)(ws + WS_WIN), scr, it, c.lane);
    } else {
        constexpr int NITEMS = I_OUT + 2 * I_W1 + 2 * I_W2 + I_QA + I_DKV + I_QB + I_UKV + I_O;
        for (int it = gw; it < NITEMS; it += NGW) {
            int r = it;
            if (r < I_OUT) { p0_transpose_item(a.in[11], 1024, 1024, 1024, (bf16_t*)(ws + WS_WOUT), scr, r, c.lane); continue; } r -= I_OUT;
            if (r < I_W1) { p0_transpose_item(a.in[6], 4096, 4096, 1024, (bf16_t*)(ws + WS_W1A), scr, r, c.lane); continue; } r -= I_W1;
            if (r < I_W2) { p0_transpose_item(a.in[7], 1024, 1024, 4096, (bf16_t*)(ws + WS_W2A), scr, r, c.lane); continue; } r -= I_W2;
            if (r < I_W1) { p0_transpose_item(a.in[6] + (size_t)1024 * 4096, 4096, 4096, 1024, (bf16_t*)(ws + WS_W1B), scr, r, c.lane); continue; } r -= I_W1;
            if (r < I_W2) { p0_transpose_item(a.in[7] + (size_t)4096 * 1024, 1024, 1024, 4096, (bf16_t*)(ws + WS_W2B), scr, r, c.lane); continue; } r -= I_W2;
            if (r < I_QA) { p0_transpose_item(a.in[12], 384, 384, 1024, (bf16_t*)(ws + WS_WQA), scr, r, c.lane); continue; } r -= I_QA;
            if (r < I_DKV) { p0_transpose_item(a.in[19], 320, 320, 1024, (bf16_t*)(ws + WS_WDKV), scr, r, c.lane); continue; } r -= I_DKV;
            if (r < I_QB) { p0_transpose_item(a.in[14], 1536, 1536, 384, (bf16_t*)(ws + WS_WQB), scr, r, c.lane); continue; } r -= I_QB;
            if (r < I_UKV) { p0_transpose_item(a.in[21], 2048, 2048, 256, (bf16_t*)(ws + WS_WUKV), scr, r, c.lane); continue; } r -= I_UKV;
            p0_transpose_item(a.in[15], 1024, 1024, 1024, (bf16_t*)(ws + WS_WO), scr, r, c.lane);
        }
        const int gt = bidx * 512 + c.tid, NT = nblk * 512; const u32x4 z = {0u, 0u, 0u, 0u};
        u32x4* p1 = (u32x4*)(ws + WS_WQA + (size_t)384 * 1024 * 2); for (int i = gt; i < 128 * 1024 * 2 / 16; i += NT) p1[i] = z;
        u32x4* p2 = (u32x4*)(ws + WS_WDKV + (size_t)320 * 1024 * 2); for (int i = gt; i < 192 * 1024 * 2 / 16; i += NT) p2[i] = z;
    }
}

__device__ __forceinline__ void p0_prologue(const Ctx& c, const Args& a) {
    unsigned char* ws = c.ws;
    LAS float* cact = (LAS float*)(c.lds + 69632);
    LAS float* red = (LAS float*)(c.lds + 86016);
    for (int i = c.tid; i < 4096; i += 512) { const float cv = a.in[1][i]; cact[i] = cv / (1.f + expf(-cv)); }
    __syncthreads();
    float* MODS = (float*)(ws + WS_MODS);
    for (int cgp = blockIdx.x; cgp < 224; cgp += c.G) {
        const int gcb = cgp * 64; const float* W; int ld, colb, dstride; const float* bias; float* dst;
        if (gcb < 12288) { const int l = gcb / 6144; colb = gcb - l * 6144; W = a.in[3] + (size_t)l * 1024 * 6144; ld = 6144; bias = a.in[4] + l * 6144; dst = MODS + l * 4 * 6144; dstride = 6144; }
        else { colb = gcb - 12288; W = a.in[16]; ld = 2048; bias = a.in[17]; dst = MODS + 49152; dstride = 2048; }
        float acc0 = 0.f, acc1 = 0.f, acc2 = 0.f, acc3 = 0.f;
        const float* wp = W + (size_t)(128 * c.wave) * ld + colb + c.lane;
#pragma unroll 16
        for (int k = 0; k < 128; ++k) { const float wv = wp[(size_t)k * ld]; const int kk = 128 * c.wave + k;
            acc0 += cact[kk] * wv; acc1 += cact[1024 + kk] * wv; acc2 += cact[2048 + kk] * wv; acc3 += cact[3072 + kk] * wv; }
        red[(c.wave * 4 + 0) * 64 + c.lane] = acc0; red[(c.wave * 4 + 1) * 64 + c.lane] = acc1; red[(c.wave * 4 + 2) * 64 + c.lane] = acc2; red[(c.wave * 4 + 3) * 64 + c.lane] = acc3;
        __syncthreads();
        if (c.tid < 256) { const int b = c.tid >> 6, l = c.tid & 63; float s = 0.f;
#pragma unroll
            for (int w = 0; w < 8; ++w) s += red[(w * 4 + b) * 64 + l];
            dst[b * dstride + colb + l] = s + bias[colb + l]; }
        __syncthreads();
    }
    p0_weights(c, a, 0, blockIdx.x, c.G);
    if (c.G != 256) p0_weights(c, a, 1, blockIdx.x, c.G);
}

template <bool HASY, int XIN  , int XOUT  , int NHN, bool GATES>
__device__ __forceinline__ void normpass(const Ctx& c, const void* xin, const bf16_t* Y, const float* gate, int gstride, const float* gpost, void* xout,
                                         bf16_t* hn0, const float* gain0, const float* sh0, const float* sc0, int st0,
                                         bf16_t* hn1, const float* gain1, const float* sh1, const float* sc1, int st1,
                                         const float* w_in, const float* bg, float* gates_out) {
    LAS float* wg = (LAS float*)c.lds;
    if (GATES) { for (int i = c.tid; i < 8192; i += 512) wg[(i & 7) * 1024 + (i >> 3)] = w_in[(size_t)(i >> 3) * APROJ + APN + (i & 7)]; __syncthreads(); }
    const int gw = blockIdx.x * 8 + c.wave, NGW = c.G * 8, lane = c.lane;
    for (int m0 = gw * 16; m0 < M; m0 += NGW * 16) {
        const int b = m0 >> 13;
        f32x4 Gv[4], A0[4], B0[4], A1[4], B1[4];
#pragma unroll
        for (int j = 0; j < 4; ++j) {
            if (HASY) Gv[j] = ((const f32x4*)gpost)[lane + 64 * j] * ((const f32x4*)(gate + (size_t)b * gstride))[lane + 64 * j];
            if (NHN > 0) { A0[j] = ((const f32x4*)gain0)[lane + 64 * j] * (((const f32x4*)(sc0 + (size_t)b * st0))[lane + 64 * j] + 1.f); B0[j] = ((const f32x4*)(sh0 + (size_t)b * st0))[lane + 64 * j]; }
            if (NHN > 1) { A1[j] = ((const f32x4*)gain1)[lane + 64 * j] * (((const f32x4*)(sc1 + (size_t)b * st1))[lane + 64 * j] + 1.f); B1[j] = ((const f32x4*)(sh1 + (size_t)b * st1))[lane + 64 * j]; }
        }
#pragma unroll 2
        for (int i = 0; i < 16; ++i) {
            const int m = m0 + i;
            f32x4 v[4];
            if (XIN == 0) { const f32x4* xr = (const f32x4*)((const float*)xin + (size_t)m * DM) + lane;
#pragma unroll
                for (int j = 0; j < 4; ++j) v[j] = xr[64 * j]; }
            else { const u32x2* xr = (const u32x2*)((const bf16_t*)xin + (size_t)m * DM) + lane;
#pragma unroll
                for (int j = 0; j < 4; ++j) { const u32x2 u = xr[64 * j]; v[j] = (f32x4){bflo(u.x), bfhi(u.x), bflo(u.y), bfhi(u.y)}; } }
            if (HASY) {
                const u32x2* yr = (const u32x2*)(Y + (size_t)m * DM) + lane; f32x4 y[4]; float ss = 0.f;
#pragma unroll
                for (int j = 0; j < 4; ++j) { const u32x2 u = yr[64 * j]; y[j] = (f32x4){bflo(u.x), bfhi(u.x), bflo(u.y), bfhi(u.y)}; ss += (y[j][0] * y[j][0] + y[j][1] * y[j][1]) + (y[j][2] * y[j][2] + y[j][3] * y[j][3]); }
                ss = wave_sum(ss); const float rs = __builtin_amdgcn_rsqf(ss * (1.f / DM) + EPS);
#pragma unroll
                for (int j = 0; j < 4; ++j) v[j] += Gv[j] * (y[j] * rs);
            }
            if (XOUT == 1) { f32x4* xo = (f32x4*)((float*)xout + (size_t)m * DM) + lane;
#pragma unroll
                for (int j = 0; j < 4; ++j) xo[64 * j] = v[j]; }
            if (XOUT == 2) { u32x2* xo = (u32x2*)((bf16_t*)xout + (size_t)m * DM) + lane;
#pragma unroll
                for (int j = 0; j < 4; ++j) { u32x2 wq; wq.x = cvtpk(v[j][0], v[j][1]); wq.y = cvtpk(v[j][2], v[j][3]); xo[64 * j] = wq; v[j] = (f32x4){bflo(wq.x), bfhi(wq.x), bflo(wq.y), bfhi(wq.y)}; } }
            if (NHN > 0) {
                float ss = 0.f;
#pragma unroll
                for (int j = 0; j < 4; ++j) ss += (v[j][0] * v[j][0] + v[j][1] * v[j][1]) + (v[j][2] * v[j][2] + v[j][3] * v[j][3]);
                ss = wave_sum(ss); const float rs = __builtin_amdgcn_rsqf(ss * (1.f / DM) + EPS);
                float ga[8];
#pragma unroll
                for (int g = 0; g < 8; ++g) ga[g] = 0.f;
                u32x2* h0 = (u32x2*)(hn0 + (size_t)m * DM) + lane;
#pragma unroll
                for (int j = 0; j < 4; ++j) { const f32x4 h = (v[j] * rs) * A0[j] + B0[j]; u32x2 w; w.x = cvtpk(h[0], h[1]); w.y = cvtpk(h[2], h[3]); h0[64 * j] = w;
                    if (GATES) {
#pragma unroll
                        for (int g = 0; g < 8; ++g) { const f32x4 w4 = *(const LAS f32x4*)(wg + g * 1024 + 256 * j + 4 * lane);
                            ga[g] += (h[0] * w4[0] + h[1] * w4[1]) + (h[2] * w4[2] + h[3] * w4[3]); }
                    } }
                if (GATES) {
#pragma unroll
                    for (int g = 0; g < 8; ++g) ga[g] = wave_sum(ga[g]);
                    if (lane == 0) {
#pragma unroll
                        for (int g = 0; g < 8; ++g) gates_out[(size_t)m * 8 + g] = ga[g] + bg[g]; }
                }
                if (NHN > 1) { u32x2* h1 = (u32x2*)(hn1 + (size_t)m * DM) + lane;
#pragma unroll
                    for (int j = 0; j < 4; ++j) { const f32x4 h = (v[j] * rs) * A1[j] + B1[j]; u32x2 w; w.x = cvtpk(h[0], h[1]); w.y = cvtpk(h[2], h[3]); h1[64 * j] = w; } }
            }
        }
    }
}

__device__ __forceinline__ void gate_scan(const Ctx& c) {
    if (blockIdx.x >= 16) return;
    const int bh = blockIdx.x, b = bh >> 2, h = bh & 3, lane = c.lane;
    const float* GATES = (const float*)(c.ws + WS_GATES); float* BCUM = (float*)(c.ws + WS_BCUM); float* CHS = (float*)(c.ws + WS_CHS);
    LAS float* cs = (LAS float*)c.lds;
    for (int j = c.wave; j < 128; j += 8) {
        const int m = b * SEQ + 64 * j + lane;
        const float f = GATES[(size_t)m * 8 + 4 + h], ii = GATES[(size_t)m * 8 + h];
        float v = fminf(f, 0.f) - log1pf(expf(-fabsf(f)));
        v += MK_DPP_F(v, 0x111); v += MK_DPP_F(v, 0x112); v += MK_DPP_F(v, 0x114); v += MK_DPP_F(v, 0x118);
        { const float r0 = __shfl(v, 15), r1 = __shfl(v, 31), r2 = __shfl(v, 47); const int row = lane >> 4;
          v += (row >= 1 ? r0 : 0.f) + (row >= 2 ? r1 : 0.f) + (row >= 3 ? r2 : 0.f); }
        const float blast = __shfl(v, 63);
        const float gm = wave_max(blast - v + ii);
        BCUM[(size_t)m * 4 + h] = v;
        if (lane == 0) { cs[2 * j] = blast; cs[2 * j + 1] = gm; }
    }
    __syncthreads();
    if (c.tid == 0) { float Mx = 0.f;
        for (int j = 0; j < 128; ++j) { const float bl = cs[2 * j], gm = cs[2 * j + 1]; const float Mn = fmaxf(bl + Mx, gm); const int ch = bh * 128 + j;
            CHS[ch] = Mx; CHS[2048 + ch] = Mn; CHS[4096 + ch] = expf(bl + Mx - Mn); Mx = Mn; } }
    __syncthreads();
}

__device__ __forceinline__ float fexp(float x) { return __builtin_amdgcn_exp2f(x * 1.4426950408889634f); }
constexpr int PR_VT = 0, PR_KW = 36864, PR_AS = 55296, PR_BT = 55552, PR_BUF = 55808;
__device__ __forceinline__ void mlstm_pre(const Ctx& c, float* NUM) {
    const int tid = c.tid, lane = c.lane, w = c.wave, g = lane >> 4, cc = lane & 15, Tt = w >> 1, dvh = w & 1;
    const bf16_t* PROJ = (const bf16_t*)(c.ws + WS_PROJ); bf16_t* KWT = (bf16_t*)(c.ws + WS_KWT); bf16_t* VT = (bf16_t*)(c.ws + WS_VT);
    const float* GATES = (const float*)(c.ws + WS_GATES); const float* BCUM = (const float*)(c.ws + WS_BCUM); const float* CHS = (const float*)(c.ws + WS_CHS);
    float* WINT = (float*)(c.ws + WS_WINT); float* ENEG = (float*)(c.ws + WS_ENEG); float* DENI = (float*)(c.ws + WS_DENI);
    const float scale = 0.08838834764831845f;
    int it = 0;
    for (int ch = blockIdx.x; ch < 2048; ch += c.G, ++it) {
        LAS unsigned char* buf = c.lds + (it & 1) * PR_BUF;
        LAS unsigned short* vT = (LAS unsigned short*)(buf + PR_VT); LAS unsigned short* kT = (LAS unsigned short*)(buf + PR_KW);
        LAS float* las = (LAS float*)(buf + PR_AS); LAS float* lbt = (LAS float*)(buf + PR_BT);
        const int bh = ch >> 7, j = ch & 127, b = bh >> 2, h = bh & 3; const int row0 = b * SEQ + 64 * j;
        const float Mprev = CHS[ch], Mnew = CHS[2048 + ch];
        const int ms = row0 + lane;
        const float bt_l = BCUM[(size_t)ms * 4 + h], i_l = GATES[(size_t)ms * 8 + h];
        s16x8 vx[4], kx[2];
        { const bf16_t* vsrc = PROJ + (size_t)ms * APN + 1024 + h * 256 + 32 * w;
#pragma unroll
          for (int i = 0; i < 4; ++i) vx[i] = *(const s16x8*)(vsrc + 8 * i);
          const bf16_t* ksrc = PROJ + (size_t)ms * APN + 512 + h * 128 + 16 * w;
#pragma unroll
          for (int i = 0; i < 2; ++i) kx[i] = *(const s16x8*)(ksrc + 8 * i); }
        __builtin_amdgcn_sched_barrier(0);
        s16x8 kf[4][4], qf[4];
        { const bf16_t* kb = PROJ + (size_t)(row0 + cc) * APN + 512 + h * 128 + 8 * g;
#pragma unroll
          for (int Ts = 0; Ts < 4; ++Ts)
#pragma unroll
              for (int kk = 0; kk < 4; ++kk) kf[Ts][kk] = *(const s16x8*)(kb + (size_t)16 * Ts * APN + 32 * kk);
          const bf16_t* qb = PROJ + (size_t)(row0 + 16 * Tt + cc) * APN + h * 128 + 8 * g;
#pragma unroll
          for (int kk = 0; kk < 4; ++kk) qf[kk] = *(const s16x8*)(qb + 32 * kk); }
        __builtin_amdgcn_sched_barrier(0);
        { const float blast = __shfl(bt_l, 63);
          const float wk_l = expf(blast - bt_l + i_l - Mnew);
          if (w == 0) { las[lane] = i_l - bt_l; lbt[lane] = bt_l; }
#pragma unroll
          for (int i = 0; i < 4; ++i) {
#pragma unroll
              for (int e = 0; e < 8; ++e) vT[(32 * w + 8 * i + e) * 72 + lane] = (unsigned short)vx[i][e]; }
#pragma unroll
          for (int i = 0; i < 2; ++i) {
#pragma unroll
              for (int e = 0; e < 8; e += 2) { const unsigned pk = cvtpk(bf1((unsigned short)kx[i][e]) * wk_l, bf1((unsigned short)kx[i][e + 1]) * wk_l);
                  kT[(16 * w + 8 * i + e) * 72 + lane] = (unsigned short)(pk & 0xffffu); kT[(16 * w + 8 * i + e + 1) * 72 + lane] = (unsigned short)(pk >> 16); } } }
        __builtin_amdgcn_sched_barrier(0);
        asm volatile("s_waitcnt lgkmcnt(0)" ::: "memory"); __builtin_amdgcn_s_barrier(); asm volatile("" ::: "memory");
        f32x4 st[4];
#pragma unroll
        for (int Ts = 0; Ts < 4; ++Ts) { st[Ts] = (f32x4){0.f, 0.f, 0.f, 0.f};
#pragma unroll
            for (int kk = 0; kk < 4; ++kk) st[Ts] = MFMA16(kf[Ts][kk], qf[kk], st[Ts]); }
        const int t = 16 * Tt + cc; const float btt = lbt[t];
        f32x4 dd[4]; float dmax = -INFINITY;
#pragma unroll
        for (int Ts = 0; Ts < 4; ++Ts) { const f32x4 av = *(const LAS f32x4*)(las + 16 * Ts + 4 * g);
#pragma unroll
            for (int jj = 0; jj < 4; ++jj) { const int s = 16 * Ts + 4 * g + jj; const float d = btt + av[jj]; dd[Ts][jj] = d; if (s <= t) dmax = fmaxf(dmax, d); } }
        dmax = fmaxf(dmax, __shfl_xor(dmax, 16)); dmax = fmaxf(dmax, __shfl_xor(dmax, 32));
        const float mt = fmaxf(btt + Mprev, dmax);
        float psum = 0.f; f32x4 p[4];
#pragma unroll
        for (int Ts = 0; Ts < 4; ++Ts)
#pragma unroll
            for (int jj = 0; jj < 4; ++jj) { const int s = 16 * Ts + 4 * g + jj; const float pv = (s <= t) ? fexp(dd[Ts][jj] - mt) * st[Ts][jj] * scale : 0.f; p[Ts][jj] = pv; psum += pv; }
        psum += __shfl_xor(psum, 16); psum += __shfl_xor(psum, 32);
        const s16x8 pb0 = pack8(p[0], p[1]), pb1 = pack8(p[2], p[3]);
        bf16_t* nrow = (bf16_t*)NUM + (size_t)(row0 + t) * DM + h * 256 + 128 * dvh + 4 * g;
#pragma unroll
        for (int Td = 0; Td < 8; ++Td) {
            const LAS unsigned short* vr = vT + (128 * dvh + 16 * Td + cc) * 72 + 4 * g;
            const s16x8 a0 = cat4(*(const LAS s16x4*)(vr), *(const LAS s16x4*)(vr + 16));
            const s16x8 a1 = cat4(*(const LAS s16x4*)(vr + 32), *(const LAS s16x4*)(vr + 48));
            f32x4 o = (f32x4){0.f, 0.f, 0.f, 0.f};
            o = MFMA16(a0, pb0, o); o = MFMA16(a1, pb1, o);
            { u32x2 ow; ow.x = cvtpk(o[0], o[1]); ow.y = cvtpk(o[2], o[3]); *(u32x2*)(nrow + 16 * Td) = ow; }
        }
        if (dvh == 0 && g == 0) { const size_t ix = (size_t)(row0 + t) * 4 + h; WINT[ix] = expf(btt + Mprev - mt) * scale; ENEG[ix] = expf(-mt); DENI[ix] = psum; }
#pragma unroll
        for (int i = 0; i < 4; ++i) { const int pi = tid + 512 * i; *(s16x8*)(VT + (size_t)ch * (272 * 64) + (size_t)pi * 8) = *(const LAS s16x8*)(buf + PR_VT + (pi >> 3) * 144 + (pi & 7) * 16); }
#pragma unroll
        for (int i = 0; i < 2; ++i) { const int pi = tid + 512 * i; *(s16x8*)(KWT + (size_t)ch * 8192 + (size_t)pi * 8) = *(const LAS s16x8*)(buf + PR_KW + (pi >> 3) * 144 + (pi & 7) * 16); }
        if (tid < 128) { const short ov = (tid < 8) ? (short)0x3F80 : (short)0; const s16x8 o8 = {ov, ov, ov, ov, ov, ov, ov, ov}; *(s16x8*)(VT + (size_t)ch * (272 * 64) + (size_t)(2048 + tid) * 8) = o8; }
    }
}

constexpr int SQ_KWO = 0, SQ_QO = 16384, SQ_VTO = 32768, SQ_WO = 36864, SQ_STG = 37888, SQ_DEC = 3 * SQ_STG;
__device__ __forceinline__ void mlstm_seq(const Ctx& c, const Args& a) {
    int bh, sp;
    if (c.G == 256) { const int x = blockIdx.x & 7, li = blockIdx.x >> 3; if (li >= 18) { p0_weights(c, a, 1, (li - 18) * 8 + x, 112); return; } bh = 2 * x + li / 9; sp = li % 9; }
    else { if ((int)blockIdx.x >= 144) return; bh = blockIdx.x / 9; sp = blockIdx.x % 9; }
    const int tid = c.tid, lane = c.lane, w = c.wave, g = lane >> 4, cc = lane & 15, si = w >> 2, Tt = w & 3, sl = 2 * sp + si, b = bh >> 2, h = bh & 3;
    const bool active = sl < 17;
    const bf16_t* PROJ = (const bf16_t*)(c.ws + WS_PROJ); const bf16_t* KWT = (const bf16_t*)(c.ws + WS_KWT); const bf16_t* VT = (const bf16_t*)(c.ws + WS_VT);
    const float* CHS = (const float*)(c.ws + WS_CHS); const float* WINT = (const float*)(c.ws + WS_WINT); float* DEN = (float*)(c.ws + WS_DEN); bf16_t* INTER = (bf16_t*)(c.ws + WS_HN);
    unsigned kwoff[2], qoff[2], xoff; const bool isv = w < 4;
#pragma unroll
    for (int i = 0; i < 2; ++i) { const int I = 2 * w + i; const int row = 8 * I + (lane >> 3); kwoff[i] = (unsigned)(row * 64 + 8 * ((lane & 7) ^ (row & 7)));
        const int t = 4 * I + (lane >> 4); qoff[i] = (unsigned)(t * APN + h * 128 + 8 * ((lane & 15) ^ (t & 15))); }
    { const int rr = 8 * (w & 3) + (lane >> 3); int slc = 2 * sp + (rr >> 4); if (slc > 16) slc = 16;
      xoff = isv ? (unsigned)((16 * slc + (rr & 15)) * 64 + 8 * ((lane & 7) ^ (rr & 7))) : (unsigned)(lane * 4); }
#define SQ_DMA(k) do { const unsigned ch_ = (unsigned)(bh * 128 + (k)); const size_t row0_ = (size_t)(b * SEQ + 64 * (k)); LAS unsigned char* sb_ = c.lds + ((k) % 3) * SQ_STG; \
        __builtin_amdgcn_global_load_lds((const unsigned*)(KWT + (size_t)ch_ * 8192 + kwoff[0]), (LAS unsigned*)(sb_ + SQ_KWO + (2 * w) * 1024), 16, 0, 0); \
        __builtin_amdgcn_global_load_lds((const unsigned*)(KWT + (size_t)ch_ * 8192 + kwoff[1]), (LAS unsigned*)(sb_ + SQ_KWO + (2 * w + 1) * 1024), 16, 0, 0); \
        __builtin_amdgcn_global_load_lds((const unsigned*)(PROJ + row0_ * APN + qoff[0]), (LAS unsigned*)(sb_ + SQ_QO + (2 * w) * 1024), 16, 0, 0); \
        __builtin_amdgcn_global_load_lds((const unsigned*)(PROJ + row0_ * APN + qoff[1]), (LAS unsigned*)(sb_ + SQ_QO + (2 * w + 1) * 1024), 16, 0, 0); \
        const void* xs_ = isv ? (const void*)(VT + (size_t)ch_ * (272 * 64) + xoff) : (const void*)(WINT + row0_ * 4 + xoff); \
        __builtin_amdgcn_global_load_lds((const unsigned*)xs_, (LAS unsigned*)(sb_ + (isv ? SQ_VTO + (w & 3) * 1024 : SQ_WO)), 16, 0, 0); } while (0)
    SQ_DMA(0); SQ_DMA(1);
    LAS float* dectab = (LAS float*)(c.lds + SQ_DEC);
    if (tid < 128) dectab[tid] = CHS[4096 + bh * 128 + tid];
    constexpr int SQ_EX = SQ_DEC + 512;
    { LAS u32x4* ex = (LAS u32x4*)(c.lds + SQ_EX); for (int i = tid; i < 1024; i += 512) ex[i] = (u32x4){0u, 0u, 0u, 0u}; }
    f32x4 C0 = (f32x4){0.f, 0.f, 0.f, 0.f}, C1 = (f32x4){0.f, 0.f, 0.f, 0.f};
    s16x8 aown = (s16x8){0, 0, 0, 0, 0, 0, 0, 0};
    const int qsw = cc, ksw = cc & 7;
#pragma unroll 1
    for (int j = 0; j < 128; ++j) {
        if (j == 127) asm volatile("s_waitcnt vmcnt(0)" ::: "memory"); else if (active && j >= 2) asm volatile("s_waitcnt vmcnt(7)" ::: "memory"); else asm volatile("s_waitcnt vmcnt(5)" ::: "memory");
        asm volatile("s_waitcnt lgkmcnt(0)" ::: "memory"); __builtin_amdgcn_s_barrier(); asm volatile("" ::: "memory");
        if (j + 2 < 128) SQ_DMA(j + 2);
        if (active) {
            const LAS unsigned char* sb_ = c.lds + (j % 3) * SQ_STG; const int row_ = b * SEQ + 64 * j + 16 * Tt + cc;
            const LAS unsigned char* exr_ = c.lds + SQ_EX + (((j + 1) & 1) * 2 + si) * 4096 + lane * 16;
            f32x4 acc_ = (f32x4){0.f, 0.f, 0.f, 0.f}; const LAS unsigned char* qa_ = sb_ + SQ_QO + (16 * Tt + cc) * 256 + 8 * (g & 1);
#pragma unroll
            for (int ks = 0; ks < 4; ++ks) { const s16x8 a_ = (ks == Tt) ? aown : *(const LAS s16x8*)(exr_ + ks * 1024);
                const s16x8 b_ = cat4(*(const LAS s16x4*)(qa_ + (((4 * ks + (g >> 1)) ^ qsw) << 4)), *(const LAS s16x4*)(qa_ + (((4 * ks + 2 + (g >> 1)) ^ qsw) << 4))); acc_ = MFMA16(a_, b_, acc_); }
            const float wv_ = *(const LAS float*)(sb_ + SQ_WO + 16 * (16 * Tt + cc) + 4 * h);
            if (sl < 16) { u32x2 o_; o_.x = cvtpk(acc_[0] * wv_, acc_[1] * wv_); o_.y = cvtpk(acc_[2] * wv_, acc_[3] * wv_); *(u32x2*)(INTER + (size_t)row_ * DM + h * 256 + 16 * sl + 4 * g) = o_; }
            else if (g == 0) DEN[(size_t)row_ * 4 + h] = wv_ * acc_[0];
            const float dec_ = dectab[j]; const LAS unsigned char* ka_ = sb_ + SQ_KWO + (32 * Tt + cc) * 128; const LAS unsigned char* va_ = sb_ + SQ_VTO + (si * 16 + cc) * 128;
            const s16x8 v0_ = *(const LAS s16x8*)(va_ + ((g ^ ksw) << 4)), v1_ = *(const LAS s16x8*)(va_ + (((4 + g) ^ ksw) << 4));
            C0 = C0 * dec_; C0 = MFMA16(*(const LAS s16x8*)(ka_ + ((g ^ ksw) << 4)), v0_, C0); C0 = MFMA16(*(const LAS s16x8*)(ka_ + (((4 + g) ^ ksw) << 4)), v1_, C0);
            C1 = C1 * dec_; C1 = MFMA16(*(const LAS s16x8*)(ka_ + 16 * 128 + ((g ^ ksw) << 4)), v0_, C1); C1 = MFMA16(*(const LAS s16x8*)(ka_ + 16 * 128 + (((4 + g) ^ ksw) << 4)), v1_, C1);
            aown = pack8(C0, C1);
            *(LAS s16x8*)(c.lds + SQ_EX + ((j & 1) * 2 + si) * 4096 + Tt * 1024 + lane * 16) = aown;
        }
    }
#undef SQ_DMA
}

__device__ __forceinline__ void mlstm_post(const Ctx& c, const float* NUM, const float* head_norm, bf16_t* OUT) {
    const int gw = blockIdx.x * 8 + c.wave, NGW = c.G * 8, lane = c.lane;
    const bf16_t* PROJ = (const bf16_t*)(c.ws + WS_PROJ); const float* DEN = (const float*)(c.ws + WS_DEN); const float* ENEG = (const float*)(c.ws + WS_ENEG); const float* DENI = (const float*)(c.ws + WS_DENI);
    for (int m = gw; m < M; m += NGW) {
#pragma unroll
        for (int h = 0; h < 4; ++h) {
            const u32x2 iu = *(const u32x2*)(OUT + (size_t)m * DM + h * 256 + 4 * lane);
            const u32x2 nu = *(const u32x2*)((const bf16_t*)NUM + (size_t)m * DM + h * 256 + 4 * lane);
            const f32x4 nv = (f32x4){bflo(nu.x), bfhi(nu.x), bflo(nu.y), bfhi(nu.y)} + (f32x4){bflo(iu.x), bfhi(iu.x), bflo(iu.y), bfhi(iu.y)};
            const float den = DEN[(size_t)m * 4 + h] + DENI[(size_t)m * 4 + h], en = ENEG[(size_t)m * 4 + h];
            const float inv = __builtin_amdgcn_rcpf(fmaxf(fabsf(den), en));
            const f32x4 hv = nv * inv;
            float ss = (hv[0] * hv[0] + hv[1] * hv[1]) + (hv[2] * hv[2] + hv[3] * hv[3]); ss = wave_sum(ss);
            const float rs = __builtin_amdgcn_rsqf(ss * (1.f / 256.f) + EPS);
            const u32x2 ou = *(const u32x2*)(PROJ + (size_t)m * APN + 2048 + h * 256 + 4 * lane);
            const f32x4 op = {bflo(ou.x), bfhi(ou.x), bflo(ou.y), bfhi(ou.y)};
            const f32x4 hn = *(const f32x4*)(head_norm + h * 256 + 4 * lane);
            f32x4 r;
#pragma unroll
            for (int e = 0; e < 4; ++e) r[e] = (hv[e] * rs * hn[e]) * __builtin_amdgcn_rcpf(1.f + __builtin_amdgcn_exp2f(-1.4426950408889634f * op[e]));
            u32x2 wv; wv.x = cvtpk(r[0], r[1]); wv.y = cvtpk(r[2], r[3]);
            *(u32x2*)(OUT + (size_t)m * DM + h * 256 + 4 * lane) = wv;
        }
    }
}

__device__ __forceinline__ void rope_cs(int pos, int jf, float& cs, float& sn) {
    const float inv = exp2f(-(float)jf * (13.287712379549449f / 32.f));
    const float ang = (float)pos * inv;
    double tt = (double)ang * 0.15915494309189535; tt -= floor(tt);
    const float tf = (float)tt;
    sn = __builtin_amdgcn_sinf(tf); cs = __builtin_amdgcn_cosf(tf);
}

__device__ __forceinline__ void mla_prep(const Ctx& c, const Args& a) {
    const int gw = blockIdx.x * 8 + c.wave, NGW = c.G * 8, lane = c.lane;
    const bf16_t* CKV = (const bf16_t*)(c.ws + WS_CKV); const bf16_t* QA = (const bf16_t*)(c.ws + WS_QA);
    bf16_t* CKVN = (bf16_t*)(c.ws + WS_CKVN); bf16_t* QAN = (bf16_t*)(c.ws + WS_QAN); bf16_t* KR = (bf16_t*)(c.ws + WS_KR); float* ROPE = (float*)(c.ws + WS_ROPE);
    const int* positions = (const int*)a.in[2]; const float* kvl = a.in[20]; const float* qn = a.in[13];
    for (int m = gw; m < M; m += NGW) {
        { const u32x2 u = *(const u32x2*)(CKV + (size_t)m * 512 + 4 * lane); const f32x4 v = {bflo(u.x), bfhi(u.x), bflo(u.y), bfhi(u.y)};
          float ss = (v[0] * v[0] + v[1] * v[1]) + (v[2] * v[2] + v[3] * v[3]); ss = wave_sum(ss); const float rs = __builtin_amdgcn_rsqf(ss * (1.f / 256.f) + EPS);
          const f32x4 gn = *(const f32x4*)(kvl + 4 * lane); u32x2 w; w.x = cvtpk(v[0] * rs * gn[0], v[1] * rs * gn[1]); w.y = cvtpk(v[2] * rs * gn[2], v[3] * rs * gn[3]);
          *(u32x2*)(CKVN + (size_t)m * 256 + 4 * lane) = w; }
        if (lane < 32) { const float x1 = bf1(CKV[(size_t)m * 512 + 256 + lane]), x2 = bf1(CKV[(size_t)m * 512 + 288 + lane]); float cs, sn; rope_cs(positions[m], lane, cs, sn);
          ROPE[(size_t)m * 64 + lane] = cs; ROPE[(size_t)m * 64 + 32 + lane] = sn;
          const unsigned pk = cvtpk(x1 * cs - x2 * sn, x1 * sn + x2 * cs); KR[(size_t)m * 64 + lane] = (bf16_t)(pk & 0xffffu); KR[(size_t)m * 64 + 32 + lane] = (bf16_t)(pk >> 16); }
        { const unsigned* qp = (const unsigned*)(QA + (size_t)m * 512 + 6 * lane); const unsigned u0 = qp[0], u1 = qp[1], u2 = qp[2];
          float v[6] = {bflo(u0), bfhi(u0), bflo(u1), bfhi(u1), bflo(u2), bfhi(u2)};
          float ss = 0.f;
#pragma unroll
          for (int e = 0; e < 6; ++e) ss += v[e] * v[e];
          ss = wave_sum(ss); const float rs = __builtin_amdgcn_rsqf(ss * (1.f / 384.f) + EPS);
          const float* gq = qn + 6 * lane; unsigned* op = (unsigned*)(QAN + (size_t)m * 384 + 6 * lane);
          op[0] = cvtpk(v[0] * rs * gq[0], v[1] * rs * gq[1]); op[1] = cvtpk(v[2] * rs * gq[2], v[3] * rs * gq[3]); op[2] = cvtpk(v[4] * rs * gq[4], v[5] * rs * gq[5]); }
    }
}

constexpr int AK_STRIDE = 200, AV_STRIDE = 72, AK_BYTES = 64 * AK_STRIDE * 2, AV_BYTES = 128 * AV_STRIDE * 2, ABUF = AK_BYTES + AV_BYTES;
__device__ __forceinline__ void attn_unit(const Ctx& c, const Args& a, int b, int h, int u) {
    const bf16_t* KV = (const bf16_t*)a.out;
    const int tid = c.tid, lane = c.lane, w = c.wave, r = lane & 31, hi = lane >> 5;
    const bf16_t* Q = (const bf16_t*)(c.ws + WS_Q); const bf16_t* KR = (const bf16_t*)(c.ws + WS_KR); bf16_t* O = (bf16_t*)(c.ws + WS_HN);
    const int rowb = b * SEQ; const int qrow = rowb + 256 * u + 32 * w + r;
    const int nt = 4 * u + 4, lim = 4 * u + (w >> 1);
    const unsigned knoff = (unsigned)((rowb + (tid >> 4)) * 2048 + h * 256 + 8 * (tid & 15));
    const unsigned kroff = (unsigned)((rowb + (tid >> 3)) * 64 + 8 * (tid & 7));
    const unsigned voff = (unsigned)((rowb + 2 * (tid & 31)) * 2048 + h * 256 + 128 + 8 * (tid >> 5));
    const int vkpos = ((2 * (tid & 31)) & ~12) | (((2 * (tid & 31)) & 4) << 1) | (((2 * (tid & 31)) & 8) >> 1);
    s16x8 sk[3], sv[2];
#define ATT_LOAD(kt) do { sk[0] = *(const s16x8*)(KV + knoff + (unsigned)(kt) * (64u * 2048u)); sk[1] = *(const s16x8*)(KV + knoff + 32u * 2048u + (unsigned)(kt) * (64u * 2048u)); \
        sk[2] = *(const s16x8*)(KR + kroff + (unsigned)(kt) * (64u * 64u)); } while (0)
#define ATT_LOADV(kt) do { _Pragma("unroll") for (int i_ = 0; i_ < 2; ++i_) sv[i_] = *(const s16x8*)(KV + voff + 2048 * i_ + (unsigned)(kt) * (64u * 2048u)); } while (0)
#define ATT_STORE(bufo) do { *(LAS s16x8*)(c.lds + (bufo) + ((tid >> 4) * AK_STRIDE + 8 * (tid & 15)) * 2) = sk[0]; *(LAS s16x8*)(c.lds + (bufo) + (((tid >> 4) + 32) * AK_STRIDE + 8 * (tid & 15)) * 2) = sk[1]; \
        *(LAS s16x8*)(c.lds + (bufo) + ((tid >> 3) * AK_STRIDE + 128 + 8 * (tid & 7)) * 2) = sk[2]; \
        _Pragma("unroll") for (int e_ = 0; e_ < 8; ++e_) *(LAS unsigned*)(c.lds + (bufo) + AK_BYTES + ((8 * (tid >> 5) + e_) * AV_STRIDE + vkpos) * 2) = (unsigned)(unsigned short)sv[0][e_] | ((unsigned)(unsigned short)sv[1][e_] << 16); } while (0)
    ATT_LOAD(0); ATT_LOADV(0);
    s16x8 qf[12];
    { const bf16_t* qp = Q + (size_t)qrow * 1536 + h * 192 + 8 * hi;
#pragma unroll
      for (int kk = 0; kk < 12; ++kk) qf[kk] = *(const s16x8*)(qp + 16 * kk);
      const float* rp = (const float*)(c.ws + WS_ROPE) + (size_t)qrow * 64 + 8 * hi;
#pragma unroll
      for (int kk = 8; kk < 10; ++kk) {
          const f32x4 ca = *(const f32x4*)(rp + 16 * (kk - 8)), cb = *(const f32x4*)(rp + 16 * (kk - 8) + 4), sa = *(const f32x4*)(rp + 32 + 16 * (kk - 8)), sb = *(const f32x4*)(rp + 32 + 16 * (kk - 8) + 4);
          const float cs8[8] = {ca[0], ca[1], ca[2], ca[3], cb[0], cb[1], cb[2], cb[3]}, sn8[8] = {sa[0], sa[1], sa[2], sa[3], sb[0], sb[1], sb[2], sb[3]};
          u32x4 o1, o2;
#pragma unroll
          for (int e = 0; e < 8; e += 2) {
              const float x1a = bf1((unsigned short)qf[kk][e]), x1b = bf1((unsigned short)qf[kk][e + 1]), x2a = bf1((unsigned short)qf[kk + 2][e]), x2b = bf1((unsigned short)qf[kk + 2][e + 1]);
              o1[e >> 1] = cvtpk(x1a * cs8[e] - x2a * sn8[e], x1b * cs8[e + 1] - x2b * sn8[e + 1]); o2[e >> 1] = cvtpk(x1a * sn8[e] + x2a * cs8[e], x1b * sn8[e + 1] + x2b * cs8[e + 1]); }
          qf[kk] = __builtin_bit_cast(s16x8, o1); qf[kk + 2] = __builtin_bit_cast(s16x8, o2);
      } }
    ATT_STORE(0);
    __syncthreads();
    f32x16 o[4];
#pragma unroll
    for (int Td = 0; Td < 4; ++Td)
#pragma unroll
        for (int e = 0; e < 16; ++e) o[Td][e] = 0.f;
    float mrun = -INFINITY, lrun = 0.f;
    const float CS = 0.07216878364870322f * 1.4426950408889634f;
#pragma unroll 1
    for (int kt = 0; kt < nt; ++kt) {
        const int bufo = (kt & 1) * ABUF, nbufo = ((kt + 1) & 1) * ABUF;
        if (kt + 1 < nt) { ATT_LOAD(kt + 1); if (kt > lim) ATT_LOADV(kt + 1); }
        if (kt <= lim) {
            f32x16 s0, s1;
#pragma unroll
            for (int e = 0; e < 16; ++e) { s0[e] = 0.f; s1[e] = 0.f; }
            const LAS unsigned char* kb = c.lds + bufo + (r * AK_STRIDE + 8 * hi) * 2;
            __builtin_amdgcn_s_setprio(1);
#pragma unroll
            for (int kk = 0; kk < 12; ++kk) { const s16x8 k0 = *(const LAS s16x8*)(kb + 32 * kk), k1 = *(const LAS s16x8*)(kb + 32 * AK_STRIDE * 2 + 32 * kk);
                s0 = MFMA32(k0, qf[kk], s0); s1 = MFMA32(k1, qf[kk], s1); }
            __builtin_amdgcn_s_setprio(0);
            float mx = s0[0];
#pragma unroll
            for (int e = 0; e < 16; ++e) { mx = fmaxf(mx, s0[e]); mx = fmaxf(mx, s1[e]); }
            mx = fmaxf(mx, __shfl_xor(mx, 32));
            const float mxs = mx * CS;
            if (__any(mxs - mrun > 8.f)) {
                const float mnew = fmaxf(mrun, mxs);
                const float alpha = __builtin_amdgcn_exp2f(mrun - mnew);
                mrun = mnew; lrun *= alpha;
#pragma unroll
                for (int Td = 0; Td < 4; ++Td)
#pragma unroll
                    for (int e = 0; e < 16; ++e) o[Td][e] *= alpha;
            }
            float ps = 0.f;
#pragma unroll
            for (int e = 0; e < 16; ++e) { s0[e] = __builtin_amdgcn_exp2f(s0[e] * CS - mrun); s1[e] = __builtin_amdgcn_exp2f(s1[e] * CS - mrun); ps += s0[e] + s1[e]; }
            lrun += ps;
            s16x8 pb[4];
            { u32x4 t0, t1, t2, t3;
#pragma unroll
              for (int e = 0; e < 4; ++e) { t0[e] = cvtpk(s0[2 * e], s0[2 * e + 1]); t1[e] = cvtpk(s0[8 + 2 * e], s0[8 + 2 * e + 1]); t2[e] = cvtpk(s1[2 * e], s1[2 * e + 1]); t3[e] = cvtpk(s1[8 + 2 * e], s1[8 + 2 * e + 1]); }
              pb[0] = __builtin_bit_cast(s16x8, t0); pb[1] = __builtin_bit_cast(s16x8, t1); pb[2] = __builtin_bit_cast(s16x8, t2); pb[3] = __builtin_bit_cast(s16x8, t3); }
            if (kt + 1 < nt) ATT_LOADV(kt + 1);
            const LAS unsigned char* vb = c.lds + bufo + AK_BYTES + (r * AV_STRIDE + 8 * hi) * 2;
            __builtin_amdgcn_s_setprio(1);
#pragma unroll
            for (int Td = 0; Td < 4; ++Td)
#pragma unroll
                for (int q2 = 0; q2 < 4; ++q2) {
                    const LAS unsigned char* vp = vb + (32 * Td * AV_STRIDE + 16 * q2) * 2;
                    const s16x8 av = *(const LAS s16x8*)(vp);
                    o[Td] = MFMA32(av, pb[q2], o[Td]); }
        }
        __builtin_amdgcn_s_setprio(0);
        if (kt + 1 < nt) ATT_STORE(nbufo);
        __syncthreads();
    }
    const float ltot = lrun + __shfl_xor(lrun, 32);
    const float inv = 1.f / ltot;
    bf16_t* op = O + (size_t)qrow * DM + h * 128 + 8 * hi;
#pragma unroll
    for (int Td = 0; Td < 4; ++Td)
#pragma unroll
        for (int p = 0; p < 2; ++p) {
            const unsigned x0 = cvtpk(o[Td][8 * p] * inv, o[Td][8 * p + 1] * inv), x1 = cvtpk(o[Td][8 * p + 2] * inv, o[Td][8 * p + 3] * inv);
            const unsigned y0 = cvtpk(o[Td][8 * p + 4] * inv, o[Td][8 * p + 5] * inv), y1 = cvtpk(o[Td][8 * p + 6] * inv, o[Td][8 * p + 7] * inv);
            const auto s0 = __builtin_amdgcn_permlane32_swap(x0, y0, false, false), s1 = __builtin_amdgcn_permlane32_swap(x1, y1, false, false);
            u32x4 wv; wv.x = s0[0]; wv.y = s1[0]; wv.z = s0[1]; wv.w = s1[1];
            *(u32x4*)(op + 32 * Td + 16 * p) = wv; }
#undef ATT_LOAD
#undef ATT_LOADV
#undef ATT_STORE
}
__device__ __forceinline__ void attn_phase(const Ctx& c, const Args& a) {
    const int bx = blockIdx.x; const int vcu = (c.G % 8 == 0) ? (bx % 8) * (c.G / 8) + bx / 8 : bx;
    for (int p = vcu; p < 512; p += c.G) {
        const int bh = p >> 4, u = p & 15, b = bh >> 3, h = bh & 7;
        attn_unit(c, a, b, h, 31 - u);
        attn_unit(c, a, b, h, u);
    }
}

#define XB_TMO      128
#define XB_XCNT(j)  (256  + 64 * (j))
#define XB_XSUB(j)  (1280 + 64 * (j))
#define XB_XGEN(j)  (2304 + 64 * (j))
#define XB_TOP      3328
#define XB_TOPGEN   3392
#define XCD_BAR_WORDS 3456
#define XB_SPIN_CAP (1u << 18)

__device__ __forceinline__ unsigned xb_ld(unsigned* p)              { return __hip_atomic_load(p, __ATOMIC_RELAXED, __HIP_MEMORY_SCOPE_AGENT); }
__device__ __forceinline__ unsigned xb_add(unsigned* p, unsigned v) { return __hip_atomic_fetch_add(p, v, __ATOMIC_RELAXED, __HIP_MEMORY_SCOPE_AGENT); }
__device__ __forceinline__ unsigned xb_xcc_id() { return (unsigned)__builtin_amdgcn_s_getreg((3 << 11) | 20) & 0xFu; }
#define XB_SPIN(cond, bar) do { unsigned _sp = 0; while (cond) { __builtin_amdgcn_s_sleep(1); \
    if ((++_sp & 255u) == 0u) { if (xb_ld(&(bar)[XB_TMO])) break; if (_sp > XB_SPIN_CAP) { atomicAdd(&(bar)[XB_TMO], 1u); break; } } } } while (0)

struct XcdBarrier {
    unsigned* bar; unsigned x;
    volatile LAS unsigned* st;
};

__device__ __forceinline__ XcdBarrier xcd_barrier_post(unsigned* bar, volatile LAS unsigned* st) {
    XcdBarrier b; b.bar = bar; b.x = xb_xcc_id(); b.st = st;
    if (threadIdx.x == 0) (void)xb_add(&bar[XB_XCNT(b.x)], 1u);
    return b;
}
__device__ __forceinline__ void xcd_barrier_complete(unsigned* bar, unsigned x, unsigned& nloc, unsigned& nx) {
    const unsigned G = gridDim.x * gridDim.y * gridDim.z;
    unsigned sum, cnt, mine, sp = 0u;
    for (;;) {
        sum = 0u; cnt = 0u; mine = 0u;
#pragma unroll
        for (unsigned j = 0; j < 16; ++j) { const unsigned c = xb_ld(&bar[XB_XCNT(j)]); sum += c; cnt += (c > 0u) ? 1u : 0u; mine = (j == x) ? c : mine; }
        if (sum == G) break;
        __builtin_amdgcn_s_sleep(1);
        if ((++sp & 255u) == 0u) { if (xb_ld(&bar[XB_TMO])) break; if (sp > XB_SPIN_CAP) { atomicAdd(&bar[XB_TMO], 1u); break; } }
    }
    nloc = mine > 0u ? mine : 1u; nx = cnt > 0u ? cnt : 1u;
}

__device__ __forceinline__ void xcd_barrier(const XcdBarrier& b) {
    asm volatile("s_waitcnt vmcnt(0)" ::: "memory");
    __syncthreads();
    if (threadIdx.x == 0) {
        unsigned* bar = b.bar;
        __builtin_amdgcn_s_waitcnt(0);
        unsigned nloc = b.st[0], nx = b.st[1];
        if (nloc == 0u) { xcd_barrier_complete(bar, b.x, nloc, nx); b.st[0] = nloc; b.st[1] = nx; }
        const unsigned old = xb_add(&bar[XB_XSUB(b.x)], 1u);
        const unsigned gen = old / nloc;
        if (old + 1u == (gen + 1u) * nloc) {
            __builtin_amdgcn_fence(__ATOMIC_RELEASE, "agent");
            asm volatile("s_waitcnt vmcnt(0)" ::: "memory");
            const unsigned og = xb_add(&bar[XB_TOP], 1u);
            const unsigned tg = og / nx;
            if (og + 1u == (tg + 1u) * nx) xb_add(&bar[XB_TOPGEN], 1u);
            else XB_SPIN(xb_ld(&bar[XB_TOPGEN]) == tg, bar);
            __builtin_amdgcn_fence(__ATOMIC_ACQUIRE, "agent");
            xb_add(&bar[XB_XGEN(b.x)], 1u);
            asm volatile("s_waitcnt vmcnt(0)" ::: "memory");
        } else {
            XB_SPIN(xb_ld(&bar[XB_XGEN(b.x)]) == gen, bar);
            __builtin_amdgcn_fence(__ATOMIC_ACQUIRE, "agent");
            asm volatile("s_waitcnt vmcnt(0)" ::: "memory");
        }
    }
    __syncthreads();
}

template <int ACT>
__device__ __forceinline__ void run_gemm(const Ctx& c, const bf16_t* A, const bf16_t* Bt, int N, int K, bf16_t* Out) {
    pg8::Gemm g{A, Bt, M, N, K}; pg8::StaticOrder S; S.init(M, N, c.G, (int)blockIdx.x);
    pg8::EpiBf16<ACT> E{Out, N, nullptr, 0, 0, 1.f};
    pg8::gemm_phase<pg8::EpiBf16<ACT>, pg8::StaticOrder, true, true>(c.lds, g, S, E);
}

__global__ void __launch_bounds__(512, 2) yoco_fwd(Args a) {
    extern __shared__ __attribute__((aligned(16))) unsigned char lds_raw[];
    cg::grid_group grid = cg::this_grid();
#define c mkctx(lds_raw, a.ws)
    unsigned char* ws = a.ws;
    const float* MODS = (const float*)(ws + WS_MODS);
    const float* M0 = MODS; const float* M1 = MODS + 4 * 6144; const float* MKV = MODS + 49152;
    const float* ng = a.in[5];
    bf16_t* HN = (bf16_t*)(ws + WS_HN); bf16_t* Yb = (bf16_t*)(ws + WS_Y); bf16_t* H1 = (bf16_t*)(ws + WS_H1); bf16_t* PROJ = (bf16_t*)(ws + WS_PROJ);
    float* X = a.out; bf16_t* XB = (bf16_t*)(ws + WS_XB);
    if (threadIdx.x < 64) ((LAS unsigned*)((LAS unsigned char*)lds_raw + 131072))[threadIdx.x] = 0u;
    __syncthreads();
    XcdBarrier xbar = xcd_barrier_post((unsigned*)ws, (volatile LAS unsigned*)((LAS unsigned char*)lds_raw + 131072));
#define GSYNC() xcd_barrier(xbar)
    grid.sync();
    p0_prologue(c, a); GSYNC();
    normpass<false, 0, 0, 1, true>(c, a.in[0], nullptr, nullptr, 0, nullptr, nullptr, HN, ng + 0, M0 + 0, M0 + 1024, 6144, nullptr, nullptr, nullptr, nullptr, 0,
                                    a.in[8], a.in[9], (float*)(ws + WS_GATES));
    GSYNC();
    gate_scan(c);
    run_gemm<0>(c, HN, (const bf16_t*)(ws + WS_WIN), APN, 1024, PROJ);
    GSYNC();
    mlstm_pre(c, X); GSYNC();
    mlstm_seq(c, a); GSYNC();
    mlstm_post(c, X, a.in[10], HN); GSYNC();
    run_gemm<0>(c, HN, (const bf16_t*)(ws + WS_WOUT), 1024, 1024, Yb); GSYNC();
    normpass<true, 0, 2, 1, false>(c, a.in[0], Yb, M0 + 2048, 6144, ng + 1024, XB, HN, ng + 2048, M0 + 3072, M0 + 4096, 6144, nullptr, nullptr, nullptr, nullptr, 0, nullptr, nullptr, nullptr);
    GSYNC();
    run_gemm<2>(c, HN, (const bf16_t*)(ws + WS_W1A), DFF, 1024, H1); GSYNC();
    run_gemm<0>(c, H1, (const bf16_t*)(ws + WS_W2A), 1024, DFF, Yb); GSYNC();
    normpass<true, 1, 2, 2, false>(c, XB, Yb, M0 + 5120, 6144, ng + 3072, XB, HN, ng + 4096, M1 + 0, M1 + 1024, 6144, (bf16_t*)(ws + WS_HNKV), a.in[18], MKV + 0, MKV + 1024, 2048,
                                   nullptr, nullptr, nullptr);
    GSYNC();
    run_gemm<0>(c, (const bf16_t*)(ws + WS_HNKV), (const bf16_t*)(ws + WS_WDKV), 512, 1024, (bf16_t*)(ws + WS_CKV));
    run_gemm<0>(c, HN, (const bf16_t*)(ws + WS_WQA), 512, 1024, (bf16_t*)(ws + WS_QA));
    GSYNC();
    mla_prep(c, a); GSYNC();
    run_gemm<0>(c, (const bf16_t*)(ws + WS_CKVN), (const bf16_t*)(ws + WS_WUKV), 2048, 256, (bf16_t*)a.out);
    run_gemm<0>(c, (const bf16_t*)(ws + WS_QAN), (const bf16_t*)(ws + WS_WQB), 1536, 384, (bf16_t*)(ws + WS_Q));
    GSYNC();
    attn_phase(c, a); GSYNC();
    run_gemm<0>(c, HN, (const bf16_t*)(ws + WS_WO), 1024, 1024, Yb); GSYNC();
    normpass<true, 1, 2, 1, false>(c, XB, Yb, M1 + 2048, 6144, ng + 4096 + 1024, XB, HN, ng + 4096 + 2048, M1 + 3072, M1 + 4096, 6144, nullptr, nullptr, nullptr, nullptr, 0, nullptr, nullptr, nullptr);
    GSYNC();
    run_gemm<2>(c, HN, (const bf16_t*)(ws + WS_W1B), DFF, 1024, H1); GSYNC();
    run_gemm<0>(c, H1, (const bf16_t*)(ws + WS_W2B), 1024, DFF, Yb); GSYNC();
    normpass<true, 1, 1, 0, false>(c, XB, Yb, M1 + 5120, 6144, ng + 4096 + 3072, X, nullptr, nullptr, nullptr, nullptr, 0, nullptr, nullptr, nullptr, nullptr, 0, nullptr, nullptr, nullptr);
#undef c
}
}

extern "C" void kernel_launch(void* const* d_in, const int* in_sizes, int n_in, void* d_out, int out_size, void* d_ws, size_t ws_size, hipStream_t stream) {
    static int grid = 0;
    if (grid == 0) {
        if (n_in != 22 || out_size != mk::M * mk::DM || ws_size < mk::WS_END) { fprintf(stderr, "kernel_launch: unexpected shapes (n_in %d out %d ws %zu)\n", n_in, out_size, ws_size); grid = -1; return; }
        int dev = 0, cus = 0, per_cu = 0;
        hipGetDevice(&dev); hipDeviceGetAttribute(&cus, hipDeviceAttributeMultiprocessorCount, dev);
        hipFuncSetAttribute((const void*)mk::yoco_fwd, hipFuncAttributeMaxDynamicSharedMemorySize, mk::LDS_BYTES);
        hipOccupancyMaxActiveBlocksPerMultiprocessor(&per_cu, (const void*)mk::yoco_fwd, 512, mk::LDS_BYTES);
        if (per_cu < 1) per_cu = 1;
        grid = cus * 1;
        (void)hipGetLastError();
    }
    if (grid < 0) return;
    mk::Args a{};
    for (int i = 0; i < 22; ++i) a.in[i] = (const float*)d_in[i];
    a.out = (float*)d_out; a.ws = (unsigned char*)d_ws;
    void* args[] = {&a};
    if (hipMemsetAsync(d_ws, 0, 65536, stream) != hipSuccess) { fprintf(stderr, "kernel_launch: memset of the barrier words failed\n"); return; }
    hipError_t e = hipLaunchCooperativeKernel((const void*)mk::yoco_fwd, dim3(grid), dim3(512), args, mk::LDS_BYTES, stream);
    if (e != hipSuccess) fprintf(stderr, "cooperative launch failed: %s (grid %d)\n", hipGetErrorString(e), grid);
}
```

```cpp
#include <hip/hip_runtime.h>
#include <hip/hip_bf16.h>
#include <cmath>
#include <cstdio>
#include <cstdint>
namespace pg8 {
#define PG8_LAS __attribute__((address_space(3)))
typedef unsigned short bf16_t;
typedef short bf16x8 __attribute__((ext_vector_type(8)));
typedef float f32x4 __attribute__((ext_vector_type(4)));
typedef unsigned u32x4 __attribute__((ext_vector_type(4)));
constexpr int BM = 256, BK = 64, HALF = 128, HTB = HALF * BK * 2  , STAGE_BYTES = 8 * HTB, NXCD = 8, WGM = 8;

__host__ __device__ __forceinline__ int lds_byte(int r, int c) { const int st = (r >> 4) * 2 + (c >> 5), rr = r & 15, cc = c & 31, ob = rr * 64 + cc * 2; return st * 1024 + (ob ^ (((ob >> 9) & 1) << 5)); }
__host__ __device__ __forceinline__ void stage_rc(int b, int& R, int& C) { const int st = b / 1024, sb = b % 1024, swz = sb ^ (((sb >> 9) & 1) << 5); R = (st >> 1) * 16 + swz / 64; C = (st & 1) * 32 + (swz % 64) / 2; }
__host__ __device__ __forceinline__ int perm32(int rho) { const int n = rho >> 4, i = rho & 15; return 8 * (i >> 2) + 4 * n + (i & 3); }

struct Unit { int pm, pn; };
struct Gemm { const bf16_t* A; const bf16_t* Bt; int M, N, K; };

struct StaticOrder {
    int nM, nN, nwg, G, c;
    __host__ __device__ void init(int M, int N, int G_, int c_) { nM = M / BM; nN = N / BM; nwg = nM * nN; G = G_; c = c_; }
    __host__ __device__ bool next(int i, Unit& u) const {
        const long L = (long)i * G + c; if (L >= nwg) return false;
        int wgid = (int)L; { const int q = nwg / NXCD, r = nwg % NXCD, xcd = wgid % NXCD, off = wgid / NXCD; wgid = (xcd < r ? xcd * (q + 1) : r * (q + 1) + (xcd - r) * q) + off; }
        const int nig = WGM * nN, gid = wgid / nig, fm = gid * WGM, gsz = (nM - fm) < WGM ? (nM - fm) : WGM;
        u.pm = fm + ((wgid % nig) % gsz); u.pn = (wgid % nig) / gsz; return true;
    }
    __device__ __forceinline__ void a_ready(const Unit&) const {}
    __device__ __forceinline__ void done(const Unit&) const {}
};

__device__ __forceinline__ unsigned cvt_pk_bf16(float lo, float hi) { unsigned r; asm volatile("v_cvt_pk_bf16_f32 %0, %1, %2" : "=v"(r) : "v"(lo), "v"(hi)); return r; }
typedef float f32x2 __attribute__((ext_vector_type(2)));
__device__ __forceinline__ f32x2 gelu_pk(f32x2 v) {
    const f32x2 av = __builtin_elementwise_abs(v), d = av * 0.2316418882f + 1.0f;
    f32x2 t; t.x = __builtin_amdgcn_rcpf(d.x); t.y = __builtin_amdgcn_rcpf(d.y);
    f32x2 q = t * 0.5307027145f + (-0.7265760135f); q = q * t + 0.7107068705f; q = q * t + (-0.142248368f); q = q * t + 0.127414796f; q = q * t;
    const f32x2 s = (v * v) * (-0.72134752044f);
    f32x2 e; e.x = __builtin_amdgcn_exp2f(s.x); e.y = __builtin_amdgcn_exp2f(s.y);
    const f32x2 m = v * (q * e), r = v - m;
    f32x2 o; o.x = v.x < 0.f ? m.x : r.x; o.y = v.y < 0.f ? m.y : r.y; return o;
}

template <int ACT  > struct EpiBf16 {
    static constexpr bool PERM = true, AFTER_DRAIN = false; static_assert(ACT == 0 || ACT == 1 || ACT == 2, "EpiBf16: ACT is 0 (none), 1 (gelu_pk) or 2 (squared relu)");
    bf16_t* O; int ldc; const float* bias; int split_cols; size_t split_stride; float scale0;
    __device__ __forceinline__ void operator()(const f32x4 (&acc)[2][2][4][2], const Unit& u, int wr, int wc, int fr, int fq) const {
        const int row0 = u.pm * BM + wr * 64 + fr; int colt = u.pn * BM; bf16_t* base = O;
        float sc = 1.f; if (split_cols) { const int t = colt / split_cols; base += (size_t)t * split_stride; colt -= t * split_cols; if (t == 0) sc = scale0; }
        const int col0 = colt + wc * 32 + 8 * fq, bcol0 = u.pn * BM + wc * 32 + 8 * fq;
        f32x4 bv[2][2];
#pragma unroll
        for (int bj = 0; bj < 2; ++bj)
#pragma unroll
            for (int n = 0; n < 2; ++n) bv[bj][n] = bias ? *(const f32x4*)(bias + bcol0 + bj * HALF + 4 * n) : (f32x4){0.f, 0.f, 0.f, 0.f};
#pragma unroll
        for (int ai = 0; ai < 2; ++ai)
#pragma unroll
            for (int m = 0; m < 4; ++m) { bf16_t* rowp = base + (size_t)(row0 + ai * HALF + m * 16) * ldc + col0;
#pragma unroll
                for (int bj = 0; bj < 2; ++bj) { f32x4 v0 = acc[ai][bj][m][0] + bv[bj][0], v1 = acc[ai][bj][m][1] + bv[bj][1];
                    if (ACT == 1) { f32x2 a = gelu_pk((f32x2){v0[0], v0[1]}), b = gelu_pk((f32x2){v0[2], v0[3]}), c = gelu_pk((f32x2){v1[0], v1[1]}), d = gelu_pk((f32x2){v1[2], v1[3]});
                        v0 = (f32x4){a.x, a.y, b.x, b.y}; v1 = (f32x4){c.x, c.y, d.x, d.y}; }
                    if (ACT == 2) { const f32x4 z = {0.f, 0.f, 0.f, 0.f}; v0 = __builtin_elementwise_max(v0, z); v1 = __builtin_elementwise_max(v1, z); v0 = v0 * v0; v1 = v1 * v1; }
                    v0 = v0 * sc; v1 = v1 * sc; u32x4 w; w.x = cvt_pk_bf16(v0[0], v0[1]); w.y = cvt_pk_bf16(v0[2], v0[3]); w.z = cvt_pk_bf16(v1[0], v1[1]); w.w = cvt_pk_bf16(v1[2], v1[3]);
                    *(u32x4*)(rowp + bj * HALF) = w; } }
    }
};

template <class Epi, class Sched, bool ALIGN_EPI = false, bool SP2 = false>
__device__ __forceinline__ void gemm_phase(PG8_LAS unsigned char* lds, const Gemm g, const Sched& S, const Epi& E) {
    const int tid = threadIdx.x, wid = __builtin_amdgcn_readfirstlane(tid >> 6), lane = tid & 63, wr = wid >> 2, wc = wid & 3, fr = lane & 15, fq = lane >> 4;
    const int K = g.K, nt = K / BK;
    unsigned voffA[2], voffB[2];
#pragma unroll
    for (int i = 0; i < 2; ++i) { int R, C; stage_rc(tid * 16 + i * 8192, R, C); const int Rb = Epi::PERM ? ((R & ~31) + perm32(R & 31)) : R;
        voffA[i] = (unsigned)(R * K + C) * 2u; voffB[i] = (unsigned)(Rb * K + C) * 2u; }
    const size_t kstep = (size_t)(BK * 2);
    const size_t hstep = (size_t)HALF * K * 2;
    const size_t tstep = 2 * hstep;
    const unsigned ldsw = (unsigned)wid * 1024u;
    const int aoff = lds_byte(wr * 64 + fr, fq * 8), boff = lds_byte(wc * 32 + fr, fq * 8);
#define PG8_SA(b, h) (((b) * 2 + (h)) * HTB)
#define PG8_SB(b, h) ((4 + (b) * 2 + (h)) * HTB)
#define PG8_STAGE(bufoff, gbase, voff) do { _Pragma("unroll") for (int _i = 0; _i < 2; ++_i) \
        __builtin_amdgcn_global_load_lds((const unsigned*)((const char*)(gbase) + (voff)[_i]), (PG8_LAS unsigned*)(lds + (bufoff) + ldsw + _i * 8192), 16, 0, 0); } while (0)
#define PG8_LDA(dst, b, h) do { _Pragma("unroll") for (int m = 0; m < 4; ++m) _Pragma("unroll") for (int k = 0; k < 2; ++k) dst[m][k] = *(const PG8_LAS bf16x8*)(lds + PG8_SA(b, h) + aoff + m * 2048 + k * 1024); } while (0)
#define PG8_LDB(dst, b, h) do { _Pragma("unroll") for (int n = 0; n < 2; ++n) _Pragma("unroll") for (int k = 0; k < 2; ++k) dst[n][k] = *(const PG8_LAS bf16x8*)(lds + PG8_SB(b, h) + boff + n * 2048 + k * 1024); } while (0)
#define PG8_MMA(ai, bj, At, Bt) do { __builtin_amdgcn_s_setprio(1); _Pragma("unroll") for (int m = 0; m < 4; ++m) _Pragma("unroll") for (int n = 0; n < 2; ++n) _Pragma("unroll") for (int k = 0; k < 2; ++k) \
        acc[ai][bj][m][n] = __builtin_amdgcn_mfma_f32_16x16x32_bf16(Bt[n][k], At[m][k], acc[ai][bj][m][n], 0, 0, 0); __builtin_amdgcn_s_setprio(0); } while (0)
#define PG8_WAIT_V(n) asm volatile("s_waitcnt vmcnt(" #n ")" ::: "memory")
#define PG8_WAIT_L(n) asm volatile("s_waitcnt lgkmcnt(" #n ")" ::: "memory")
#define PG8_BAR __builtin_amdgcn_s_barrier()
#define PG8_SCHED __builtin_amdgcn_sched_barrier(0)
    Unit cur, nxt; int ui = 0;
    if (!S.next(0, cur)) return;
    f32x4 acc[2][2][4][2];
#pragma unroll
    for (int a = 0; a < 2; ++a)
#pragma unroll
        for (int b = 0; b < 2; ++b)
#pragma unroll
            for (int m = 0; m < 4; ++m)
#pragma unroll
                for (int n = 0; n < 2; ++n) acc[a][b][m][n] = (f32x4){0.f, 0.f, 0.f, 0.f};
    bf16x8 At[4][2], B0[2][2], B1[2][2];
    const char* cA = (const char*)g.A + (size_t)cur.pm * tstep; const char* cB = (const char*)g.Bt + (size_t)cur.pn * tstep;
    S.a_ready(cur);
    if constexpr (SP2) {
        PG8_STAGE(PG8_SB(0, 0), cB, voffB); PG8_STAGE(PG8_SB(0, 1), cB + hstep, voffB); PG8_STAGE(PG8_SA(0, 0), cA, voffA); PG8_STAGE(PG8_SA(0, 1), cA + hstep, voffA);
        if (wr == 1) PG8_BAR;
        PG8_WAIT_V(2); PG8_BAR;
        PG8_STAGE(PG8_SB(1, 0), cB + kstep, voffB); PG8_STAGE(PG8_SA(1, 0), cA + kstep, voffA); PG8_STAGE(PG8_SB(1, 1), cB + hstep + kstep, voffB);
        PG8_WAIT_V(6); PG8_BAR;
    } else {
        PG8_STAGE(PG8_SB(0, 0), cB, voffB); PG8_STAGE(PG8_SA(0, 0), cA, voffA); PG8_STAGE(PG8_SB(0, 1), cB + hstep, voffB); PG8_STAGE(PG8_SA(0, 1), cA + hstep, voffA);
        if (wr == 1) PG8_BAR;
        PG8_WAIT_V(4); PG8_BAR;
        PG8_STAGE(PG8_SB(1, 0), cB + kstep, voffB); PG8_STAGE(PG8_SA(1, 0), cA + kstep, voffA); PG8_STAGE(PG8_SB(1, 1), cB + hstep + kstep, voffB);
        PG8_WAIT_V(6); PG8_BAR;
    }
    for (;;) {
        const bool has_next = S.next(ui + 1, nxt);
        const char* nA = has_next ? (const char*)g.A + (size_t)nxt.pm * tstep : cA; const char* nB = has_next ? (const char*)g.Bt + (size_t)nxt.pn * tstep : cB;
        for (int t = 0; t < nt; t += 2) {
            const bool last = (t == nt - 2);
            const char* a1 = cA + (size_t)(t + 1) * kstep;
            const char* a2 = last ? nA : cA + (size_t)(t + 2) * kstep; const char* b2 = last ? nB : cB + (size_t)(t + 2) * kstep;
            const char* a3 = a2 + kstep; const char* b3 = b2 + kstep;
            if (last && has_next) S.a_ready(nxt);
            if constexpr (SP2) {
            PG8_LDB(B0, 0, 0); PG8_LDB(B1, 0, 1); PG8_SCHED; PG8_LDA(At, 0, 0); PG8_STAGE(PG8_SA(1, 1), a1 + hstep, voffA);
            PG8_WAIT_V(8); PG8_WAIT_L(0); PG8_BAR; PG8_MMA(0, 0, At, B0); PG8_MMA(0, 1, At, B1); PG8_BAR; PG8_SCHED;
            PG8_LDA(At, 0, 1); PG8_STAGE(PG8_SB(0, 0), b2, voffB); PG8_STAGE(PG8_SB(0, 1), b2 + hstep, voffB); PG8_STAGE(PG8_SA(0, 0), a2, voffA);
            PG8_WAIT_V(8); PG8_WAIT_L(0); PG8_BAR; PG8_MMA(1, 0, At, B0); PG8_MMA(1, 1, At, B1); PG8_BAR; PG8_SCHED;
            PG8_LDB(B0, 1, 0); PG8_LDB(B1, 1, 1); PG8_SCHED; PG8_LDA(At, 1, 0); PG8_STAGE(PG8_SA(0, 1), a2 + hstep, voffA);
            PG8_WAIT_V(8); PG8_WAIT_L(0); PG8_BAR; PG8_MMA(0, 0, At, B0); PG8_MMA(0, 1, At, B1); PG8_BAR; PG8_SCHED;
            PG8_LDA(At, 1, 1); PG8_STAGE(PG8_SB(1, 0), b3, voffB); PG8_STAGE(PG8_SB(1, 1), b3 + hstep, voffB); PG8_STAGE(PG8_SA(1, 0), a3, voffA);
            PG8_WAIT_V(8); PG8_WAIT_L(0); PG8_BAR; PG8_MMA(1, 0, At, B0); PG8_MMA(1, 1, At, B1); PG8_BAR; PG8_SCHED;
            } else {
            PG8_LDB(B0, 0, 0); PG8_SCHED; PG8_LDA(At, 0, 0); PG8_STAGE(PG8_SA(1, 1), a1 + hstep, voffA);
            PG8_WAIT_L(8); PG8_BAR; PG8_WAIT_L(0); PG8_MMA(0, 0, At, B0); PG8_BAR; PG8_SCHED;
            PG8_LDB(B1, 0, 1); PG8_STAGE(PG8_SB(0, 0), b2, voffB);
            PG8_BAR; PG8_WAIT_L(0); PG8_MMA(0, 1, At, B1); PG8_BAR;
            PG8_LDA(At, 0, 1); PG8_STAGE(PG8_SA(0, 0), a2, voffA);
            PG8_BAR; PG8_WAIT_L(0); PG8_MMA(1, 0, At, B0); PG8_BAR; PG8_SCHED;
            PG8_STAGE(PG8_SB(0, 1), b2 + hstep, voffB);
            PG8_WAIT_V(6); PG8_BAR; PG8_MMA(1, 1, At, B1); PG8_BAR;
            PG8_LDB(B0, 1, 0); PG8_SCHED; PG8_LDA(At, 1, 0); PG8_STAGE(PG8_SA(0, 1), a2 + hstep, voffA);
            PG8_WAIT_L(8); PG8_BAR; PG8_WAIT_L(0); PG8_MMA(0, 0, At, B0); PG8_BAR; PG8_SCHED;
            PG8_LDB(B1, 1, 1); PG8_STAGE(PG8_SB(1, 0), b3, voffB);
            PG8_BAR; PG8_WAIT_L(0); PG8_MMA(0, 1, At, B1); PG8_BAR;
            PG8_LDA(At, 1, 1); PG8_STAGE(PG8_SA(1, 0), a3, voffA);
            PG8_BAR; PG8_WAIT_L(0); PG8_MMA(1, 0, At, B0); PG8_BAR; PG8_SCHED;
            PG8_STAGE(PG8_SB(1, 1), b3 + hstep, voffB);
            PG8_WAIT_V(6); PG8_BAR; PG8_MMA(1, 1, At, B1); PG8_BAR;
            }
        }
        if constexpr (ALIGN_EPI) { if (wr == 0) PG8_BAR; }
        if constexpr (!Epi::AFTER_DRAIN) { E(acc, cur, wr, wc, fr, fq); S.done(cur); }
        if (!has_next) break;
#pragma unroll
        for (int a = 0; a < 2; ++a)
#pragma unroll
            for (int b = 0; b < 2; ++b)
#pragma unroll
                for (int m = 0; m < 4; ++m)
#pragma unroll
                    for (int n = 0; n < 2; ++n) acc[a][b][m][n] = (f32x4){0.f, 0.f, 0.f, 0.f};
        cur = nxt; cA = nA; cB = nB; ++ui;
        if constexpr (ALIGN_EPI) { if (wr == 1) PG8_BAR; }
    }
    PG8_WAIT_V(0);
    if constexpr (!ALIGN_EPI) { if (wr == 0) PG8_BAR; }
    PG8_BAR;
    if constexpr (Epi::AFTER_DRAIN) { E.fused(acc, cur, wr, wc, fr, fq, lds, wid, lane); S.done(cur); }
#undef PG8_SA
#undef PG8_SB
#undef PG8_STAGE
#undef PG8_LDA
#undef PG8_LDB
#undef PG8_MMA
#undef PG8_WAIT_V
#undef PG8_WAIT_L
#undef PG8_BAR
#undef PG8_SCHED
}
}


#include <hip/hip_cooperative_groups.h>
namespace cg = cooperative_groups;
namespace mk {
#define LAS __attribute__((address_space(3)))
typedef unsigned short bf16_t;
typedef short s16x8 __attribute__((ext_vector_type(8)));
typedef short s16x4 __attribute__((ext_vector_type(4)));
typedef float f32x4 __attribute__((ext_vector_type(4)));
typedef float f32x2 __attribute__((ext_vector_type(2)));
typedef float f32x16 __attribute__((ext_vector_type(16)));
typedef unsigned u32x4 __attribute__((ext_vector_type(4)));
typedef unsigned u32x2 __attribute__((ext_vector_type(2)));
typedef __bf16 bf16x2_t __attribute__((ext_vector_type(2)));

constexpr int NB = 4, SEQ = 8192, DM = 1024, M = NB * SEQ, DFF = 4096;
constexpr int APN = 3072, APROJ = 3080;
constexpr float EPS = 1e-6f;
constexpr size_t MiB = 1u << 20;
constexpr size_t WS_MODS = 1 * MiB, WS_GATES = 2 * MiB, WS_BCUM = 3 * MiB, WS_WINT = 3 * MiB + 512 * 1024, WS_ENEG = 4 * MiB, WS_DENI = 4 * MiB + 512 * 1024, WS_DEN = 5 * MiB,
                 WS_CHS = 5 * MiB + 512 * 1024;
constexpr size_t WS_WIN = 8 * MiB, WS_WOUT = 14 * MiB, WS_W1A = 16 * MiB, WS_W2A = 24 * MiB, WS_W1B = 32 * MiB, WS_W2B = 40 * MiB, WS_WQA = 48 * MiB, WS_WDKV = 49 * MiB,
                 WS_WQB = 50 * MiB, WS_WUKV = 52 * MiB, WS_WO = 53 * MiB, WS_ROPE = 56 * MiB;
constexpr size_t WS_HN = 64 * MiB, WS_Y = 128 * MiB, WS_KWT = 128 * MiB, WS_PROJ = 192 * MiB, WS_VT = 384 * MiB, WS_H1 = 192 * MiB;
constexpr size_t WS_HNKV = 192 * MiB, WS_CKV = 256 * MiB, WS_QA = 288 * MiB, WS_CKVN = 320 * MiB, WS_QAN = 336 * MiB, WS_KR = 360 * MiB, WS_KV = 364 * MiB, WS_Q = 192 * MiB;
constexpr size_t WS_XB = 448 * MiB;
constexpr size_t WS_END = 512 * MiB;
constexpr int LDS_BYTES = 147456;

__device__ __forceinline__ unsigned cvtpk(float lo, float hi) { f32x2 v = {lo, hi}; bf16x2_t b = __builtin_convertvector(v, bf16x2_t); return __builtin_bit_cast(unsigned, b); }
__device__ __forceinline__ float bflo(unsigned u) { return __uint_as_float(u << 16); }
__device__ __forceinline__ float bfhi(unsigned u) { return __uint_as_float(u & 0xffff0000u); }
__device__ __forceinline__ float bf1(unsigned short h) { return __uint_as_float((unsigned)h << 16); }
__device__ __forceinline__ s16x8 pack8(f32x4 a, f32x4 b) { u32x4 w; w.x = cvtpk(a[0], a[1]); w.y = cvtpk(a[2], a[3]); w.z = cvtpk(b[0], b[1]); w.w = cvtpk(b[2], b[3]); return __builtin_bit_cast(s16x8, w); }
__device__ __forceinline__ s16x8 cat4(s16x4 a, s16x4 b) { return __builtin_shufflevector(a, b, 0, 1, 2, 3, 4, 5, 6, 7); }
#define MK_DPP_ADD(v, ctrl) ((v) + __uint_as_float((unsigned)__builtin_amdgcn_update_dpp(0, (int)__float_as_uint(v), (ctrl), 0xF, 0xF, true)))
__device__ __forceinline__ float wave_sum(float v) {
    v = MK_DPP_ADD(v, 0xB1); v = MK_DPP_ADD(v, 0x4E); v = MK_DPP_ADD(v, 0x141); v = MK_DPP_ADD(v, 0x140);
    v += __shfl_xor(v, 16);
    const auto rr = __builtin_amdgcn_permlane32_swap(__float_as_uint(v), __float_as_uint(v), false, false);
    return __uint_as_float(rr[0]) + __uint_as_float(rr[1]);
}
#define MK_DPP_F(v, ctrl) __uint_as_float((unsigned)__builtin_amdgcn_update_dpp(0, (int)__float_as_uint(v), (ctrl), 0xF, 0xF, true))
__device__ __forceinline__ float wave_max(float v) {
    v = fmaxf(v, MK_DPP_F(v, 0xB1)); v = fmaxf(v, MK_DPP_F(v, 0x4E)); v = fmaxf(v, MK_DPP_F(v, 0x141)); v = fmaxf(v, MK_DPP_F(v, 0x140));
    v = fmaxf(v, __shfl_xor(v, 16));
    const auto rr = __builtin_amdgcn_permlane32_swap(__float_as_uint(v), __float_as_uint(v), false, false);
    return fmaxf(__uint_as_float(rr[0]), __uint_as_float(rr[1]));
}
#define MFMA16(a, b, c) __builtin_amdgcn_mfma_f32_16x16x32_bf16((a), (b), (c), 0, 0, 0)
#define MFMA32(a, b, c) __builtin_amdgcn_mfma_f32_32x32x16_bf16((a), (b), (c), 0, 0, 0)

struct Args { const float* in[22]; float* out; unsigned char* ws; };
struct Ctx {
    LAS unsigned char* lds; unsigned char* ws; int tid, lane, wave, G;
};
__device__ __forceinline__ Ctx mkctx(unsigned char* lds_raw, unsigned char* ws) {
    Ctx c; int t = threadIdx.x; asm volatile("" : "+v"(t)); c.tid = t; c.lane = t & 63; c.wave = __builtin_amdgcn_readfirstlane(t >> 6); c.lds = (LAS unsigned char*)lds_raw; c.ws = ws; c.G = gridDim.x; return c; }

__device__ __forceinline__ void p0_transpose_item(const float* W, int ldw, int ncols, int K, bf16_t* WT, LAS float* scr, int item, int lane) {
    const int nblk = ncols / 32, kb = item / nblk, nb = item % nblk, k0 = 64 * kb, n0 = 32 * nb;
#pragma unroll 8
    for (int i = 0; i < 32; ++i) { const int kk = 2 * i + (lane >> 5); scr[kk * 33 + (lane & 31)] = W[(size_t)(k0 + kk) * ldw + n0 + (lane & 31)]; }
    asm volatile("s_waitcnt lgkmcnt(0)" ::: "memory");
    const int c = lane & 7;
#pragma unroll
    for (int j = 0; j < 4; ++j) { const int n = (lane >> 3) + 8 * j; const LAS float* s = scr + (8 * c) * 33 + n;
        u32x4 o; o.x = cvtpk(s[0 * 33], s[1 * 33]); o.y = cvtpk(s[2 * 33], s[3 * 33]); o.z = cvtpk(s[4 * 33], s[5 * 33]); o.w = cvtpk(s[6 * 33], s[7 * 33]);
        *(u32x4*)(WT + (size_t)(n0 + n) * K + k0 + 8 * c) = o; }
    asm volatile("s_waitcnt lgkmcnt(0)" ::: "memory");
}

__device__ __forceinline__ void p0_weights(const Ctx& c, const Args& a, int part, int bidx, int nblk) {
    unsigned char* ws = c.ws;
    LAS float* scr = (LAS float*)(c.lds + c.wave * 8704);
    const int gw = bidx * 8 + c.wave, NGW = nblk * 8;
    constexpr int I_IN = 16 * 96, I_OUT = 16 * 32, I_W1 = 16 * 128, I_W2 = 64 * 32, I_QA = 16 * 12, I_DKV = 16 * 10, I_QB = 6 * 48, I_UKV = 4 * 64, I_O = 16 * 32;
    if (part == 0) {
        for (int it = gw; it < I_IN; it += NGW) p0_transpose_item(a.in[8], APROJ, APN, 1024, (bf16_t*)(ws + WS_WIN), scr, it, c.lane);
    } else {
        constexpr int NITEMS = I_OUT + 2 * I_W1 + 2 * I_W2 + I_QA + I_DKV + I_QB + I_UKV + I_O;
        for (int it = gw; it < NITEMS; it += NGW) {
            int r = it;
            if (r < I_OUT) { p0_transpose_item(a.in[11], 1024, 1024, 1024, (bf16_t*)(ws + WS_WOUT), scr, r, c.lane); continue; } r -= I_OUT;
            if (r < I_W1) { p0_transpose_item(a.in[6], 4096, 4096, 1024, (bf16_t*)(ws + WS_W1A), scr, r, c.lane); continue; } r -= I_W1;
            if (r < I_W2) { p0_transpose_item(a.in[7], 1024, 1024, 4096, (bf16_t*)(ws + WS_W2A), scr, r, c.lane); continue; } r -= I_W2;
            if (r < I_W1) { p0_transpose_item(a.in[6] + (size_t)1024 * 4096, 4096, 4096, 1024, (bf16_t*)(ws + WS_W1B), scr, r, c.lane); continue; } r -= I_W1;
            if (r < I_W2) { p0_transpose_item(a.in[7] + (size_t)4096 * 1024, 1024, 1024, 4096, (bf16_t*)(ws + WS_W2B), scr, r, c.lane); continue; } r -= I_W2;
            if (r < I_QA) { p0_transpose_item(a.in[12], 384, 384, 1024, (bf16_t*)(ws + WS_WQA), scr, r, c.lane); continue; } r -= I_QA;
            if (r < I_DKV) { p0_transpose_item(a.in[19], 320, 320, 1024, (bf16_t*)(ws + WS_WDKV), scr, r, c.lane); continue; } r -= I_DKV;
            if (r < I_QB) { p0_transpose_item(a.in[14], 1536, 1536, 384, (bf16_t*)(ws + WS_WQB), scr, r, c.lane); continue; } r -= I_QB;
            if (r < I_UKV) { p0_transpose_item(a.in[21], 2048, 2048, 256, (bf16_t*)(ws + WS_WUKV), scr, r, c.lane); continue; } r -= I_UKV;
            p0_transpose_item(a.in[15], 1024, 1024, 1024, (bf16_t*)(ws + WS_WO), scr, r, c.lane);
        }
        const int gt = bidx * 512 + c.tid, NT = nblk * 512; const u32x4 z = {0u, 0u, 0u, 0u};
        u32x4* p1 = (u32x4*)(ws + WS_WQA + (size_t)384 * 1024 * 2); for (int i = gt; i < 128 * 1024 * 2 / 16; i += NT) p1[i] = z;
        u32x4* p2 = (u32x4*)(ws + WS_WDKV + (size_t)320 * 1024 * 2); for (int i = gt; i < 192 * 1024 * 2 / 16; i += NT) p2[i] = z;
    }
}

__device__ __forceinline__ void p0_prologue(const Ctx& c, const Args& a) {
    unsigned char* ws = c.ws;
    LAS float* cact = (LAS float*)(c.lds + 69632);
    LAS float* red = (LAS float*)(c.lds + 86016);
    for (int i = c.tid; i < 4096; i += 512) { const float cv = a.in[1][i]; cact[i] = cv / (1.f + expf(-cv)); }
    __syncthreads();
    float* MODS = (float*)(ws + WS_MODS);
    for (int cgp = blockIdx.x; cgp < 224; cgp += c.G) {
        const int gcb = cgp * 64; const float* W; int ld, colb, dstride; const float* bias; float* dst;
        if (gcb < 12288) { const int l = gcb / 6144; colb = gcb - l * 6144; W = a.in[3] + (size_t)l * 1024 * 6144; ld = 6144; bias = a.in[4] + l * 6144; dst = MODS + l * 4 * 6144; dstride = 6144; }
        else { colb = gcb - 12288; W = a.in[16]; ld = 2048; bias = a.in[17]; dst = MODS + 49152; dstride = 2048; }
        float acc0 = 0.f, acc1 = 0.f, acc2 = 0.f, acc3 = 0.f;
        const float* wp = W + (size_t)(128 * c.wave) * ld + colb + c.lane;
#pragma unroll 16
        for (int k = 0; k < 128; ++k) { const float wv = wp[(size_t)k * ld]; const int kk = 128 * c.wave + k;
            acc0 += cact[kk] * wv; acc1 += cact[1024 + kk] * wv; acc2 += cact[2048 + kk] * wv; acc3 += cact[3072 + kk] * wv; }
        red[(c.wave * 4 + 0) * 64 + c.lane] = acc0; red[(c.wave * 4 + 1) * 64 + c.lane] = acc1; red[(c.wave * 4 + 2) * 64 + c.lane] = acc2; red[(c.wave * 4 + 3) * 64 + c.lane] = acc3;
        __syncthreads();
        if (c.tid < 256) { const int b = c.tid >> 6, l = c.tid & 63; float s = 0.f;
#pragma unroll
            for (int w = 0; w < 8; ++w) s += red[(w * 4 + b) * 64 + l];
            dst[b * dstride + colb + l] = s + bias[colb + l]; }
        __syncthreads();
    }
    p0_weights(c, a, 0, blockIdx.x, c.G);
    if (c.G != 256) p0_weights(c, a, 1, blockIdx.x, c.G);
}

template <bool HASY, int XIN  , int XOUT  , int NHN, bool GATES>
__device__ __forceinline__ void normpass(const Ctx& c, const void* xin, const bf16_t* Y, const float* gate, int gstride, const float* gpost, void* xout,
                                         bf16_t* hn0, const float* gain0, const float* sh0, const float* sc0, int st0,
                                         bf16_t* hn1, const float* gain1, const float* sh1, const float* sc1, int st1,
                                         const float* w_in, const float* bg, float* gates_out) {
    LAS float* wg = (LAS float*)c.lds;
    if (GATES) { for (int i = c.tid; i < 8192; i += 512) wg[(i & 7) * 1024 + (i >> 3)] = w_in[(size_t)(i >> 3) * APROJ + APN + (i & 7)]; __syncthreads(); }
    const int gw = blockIdx.x * 8 + c.wave, NGW = c.G * 8, lane = c.lane;
    for (int m0 = gw * 16; m0 < M; m0 += NGW * 16) {
        const int b = m0 >> 13;
        f32x4 Gv[4], A0[4], B0[4], A1[4], B1[4];
#pragma unroll
        for (int j = 0; j < 4; ++j) {
            if (HASY) Gv[j] = ((const f32x4*)gpost)[lane + 64 * j] * ((const f32x4*)(gate + (size_t)b * gstride))[lane + 64 * j];
            if (NHN > 0) { A0[j] = ((const f32x4*)gain0)[lane + 64 * j] * (((const f32x4*)(sc0 + (size_t)b * st0))[lane + 64 * j] + 1.f); B0[j] = ((const f32x4*)(sh0 + (size_t)b * st0))[lane + 64 * j]; }
            if (NHN > 1) { A1[j] = ((const f32x4*)gain1)[lane + 64 * j] * (((const f32x4*)(sc1 + (size_t)b * st1))[lane + 64 * j] + 1.f); B1[j] = ((const f32x4*)(sh1 + (size_t)b * st1))[lane + 64 * j]; }
        }
#pragma unroll 2
        for (int i = 0; i < 16; ++i) {
            const int m = m0 + i;
            f32x4 v[4];
            if (XIN == 0) { const f32x4* xr = (const f32x4*)((const float*)xin + (size_t)m * DM) + lane;
#pragma unroll
                for (int j = 0; j < 4; ++j) v[j] = xr[64 * j]; }
            else { const u32x2* xr = (const u32x2*)((const bf16_t*)xin + (size_t)m * DM) + lane;
#pragma unroll
                for (int j = 0; j < 4; ++j) { const u32x2 u = xr[64 * j]; v[j] = (f32x4){bflo(u.x), bfhi(u.x), bflo(u.y), bfhi(u.y)}; } }
            if (HASY) {
                const u32x2* yr = (const u32x2*)(Y + (size_t)m * DM) + lane; f32x4 y[4]; float ss = 0.f;
#pragma unroll
                for (int j = 0; j < 4; ++j) { const u32x2 u = yr[64 * j]; y[j] = (f32x4){bflo(u.x), bfhi(u.x), bflo(u.y), bfhi(u.y)}; ss += (y[j][0] * y[j][0] + y[j][1] * y[j][1]) + (y[j][2] * y[j][2] + y[j][3] * y[j][3]); }
                ss = wave_sum(ss); const float rs = __builtin_amdgcn_rsqf(ss * (1.f / DM) + EPS);
#pragma unroll
                for (int j = 0; j < 4; ++j) v[j] += Gv[j] * (y[j] * rs);
            }
            if (XOUT == 1) { f32x4* xo = (f32x4*)((float*)xout + (size_t)m * DM) + lane;
#pragma unroll
                for (int j = 0; j < 4; ++j) xo[64 * j] = v[j]; }
            if (XOUT == 2) { u32x2* xo = (u32x2*)((bf16_t*)xout + (size_t)m * DM) + lane;
#pragma unroll
                for (int j = 0; j < 4; ++j) { u32x2 wq; wq.x = cvtpk(v[j][0], v[j][1]); wq.y = cvtpk(v[j][2], v[j][3]); xo[64 * j] = wq; v[j] = (f32x4){bflo(wq.x), bfhi(wq.x), bflo(wq.y), bfhi(wq.y)}; } }
            if (NHN > 0) {
                float ss = 0.f;
#pragma unroll
                for (int j = 0; j < 4; ++j) ss += (v[j][0] * v[j][0] + v[j][1] * v[j][1]) + (v[j][2] * v[j][2] + v[j][3] * v[j][3]);
                ss = wave_sum(ss); const float rs = __builtin_amdgcn_rsqf(ss * (1.f / DM) + EPS);
                float ga[8];
#pragma unroll
                for (int g = 0; g < 8; ++g) ga[g] = 0.f;
                u32x2* h0 = (u32x2*)(hn0 + (size_t)m * DM) + lane;
#pragma unroll
                for (int j = 0; j < 4; ++j) { const f32x4 h = (v[j] * rs) * A0[j] + B0[j]; u32x2 w; w.x = cvtpk(h[0], h[1]); w.y = cvtpk(h[2], h[3]); h0[64 * j] = w;
                    if (GATES) {
#pragma unroll
                        for (int g = 0; g < 8; ++g) { const f32x4 w4 = *(const LAS f32x4*)(wg + g * 1024 + 256 * j + 4 * lane);
                            ga[g] += (h[0] * w4[0] + h[1] * w4[1]) + (h[2] * w4[2] + h[3] * w4[3]); }
                    } }
                if (GATES) {
#pragma unroll
                    for (int g = 0; g < 8; ++g) ga[g] = wave_sum(ga[g]);
                    if (lane == 0) {
#pragma unroll
                        for (int g = 0; g < 8; ++g) gates_out[(size_t)m * 8 + g] = ga[g] + bg[g]; }
                }
                if (NHN > 1) { u32x2* h1 = (u32x2*)(hn1 + (size_t)m * DM) + lane;
#pragma unroll
                    for (int j = 0; j < 4; ++j) { const f32x4 h = (v[j] * rs) * A1[j] + B1[j]; u32x2 w; w.x = cvtpk(h[0], h[1]); w.y = cvtpk(h[2], h[3]); h1[64 * j] = w; } }
            }
        }
    }
}

__device__ __forceinline__ void gate_scan(const Ctx& c) {
    if (blockIdx.x >= 16) return;
    const int bh = blockIdx.x, b = bh >> 2, h = bh & 3, lane = c.lane;
    const float* GATES = (const float*)(c.ws + WS_GATES); float* BCUM = (float*)(c.ws + WS_BCUM); float* CHS = (float*)(c.ws + WS_CHS);
    LAS float* cs = (LAS float*)c.lds;
    for (int j = c.wave; j < 128; j += 8) {
        const int m = b * SEQ + 64 * j + lane;
        const float f = GATES[(size_t)m * 8 + 4 + h], ii = GATES[(size_t)m * 8 + h];
        float v = fminf(f, 0.f) - log1pf(expf(-fabsf(f)));
        v += MK_DPP_F(v, 0x111); v += MK_DPP_F(v, 0x112); v += MK_DPP_F(v, 0x114); v += MK_DPP_F(v, 0x118);
        { const float r0 = __shfl(v, 15), r1 = __shfl(v, 31), r2 = __shfl(v, 47); const int row = lane >> 4;
          v += (row >= 1 ? r0 : 0.f) + (row >= 2 ? r1 : 0.f) + (row >= 3 ? r2 : 0.f); }
        const float blast = __shfl(v, 63);
        const float gm = wave_max(blast - v + ii);
        BCUM[(size_t)m * 4 + h] = v;
        if (lane == 0) { cs[2 * j] = blast; cs[2 * j + 1] = gm; }
    }
    __syncthreads();
    { const int t = c.tid; const bool on = t < 128;
      LAS float* sA = (LAS float*)(c.lds + 2048); LAS float* sB = sA + 256;
      const float bl = on ? cs[2 * t] : 0.f; float A = bl, B = on ? cs[2 * t + 1] : -INFINITY; int p = 0;
#pragma unroll 1
      for (int o = 1; o < 128; o <<= 1) {
          if (on) { sA[p * 128 + t] = A; sB[p * 128 + t] = B; }
          __syncthreads();
          if (on && t >= o) { const float a1 = sA[p * 128 + t - o], b1 = sB[p * 128 + t - o]; B = fmaxf(b1 + A, B); A = a1 + A; }
          p ^= 1;
      }
      const float Mn = fmaxf(A, B);
      if (on) sA[p * 128 + t] = Mn;
      __syncthreads();
      if (on) { const float Mp = t ? sA[p * 128 + t - 1] : 0.f; const int ch = bh * 128 + t;
          CHS[ch] = Mp; CHS[2048 + ch] = Mn; CHS[4096 + ch] = expf(bl + Mp - Mn); } }
    __syncthreads();
}

__device__ __forceinline__ float fexp(float x) { return __builtin_amdgcn_exp2f(x * 1.4426950408889634f); }
constexpr int PR_VT = 0, PR_KW = 36864, PR_AS = 55296, PR_BT = 55552, PR_BUF = 55808;
__device__ __forceinline__ void mlstm_pre(const Ctx& c, float* NUM) {
    const int tid = c.tid, lane = c.lane, w = c.wave, g = lane >> 4, cc = lane & 15, Tt = w >> 1, dvh = w & 1;
    const bf16_t* PROJ = (const bf16_t*)(c.ws + WS_PROJ); bf16_t* KWT = (bf16_t*)(c.ws + WS_KWT); bf16_t* VT = (bf16_t*)(c.ws + WS_VT);
    const float* GATES = (const float*)(c.ws + WS_GATES); const float* BCUM = (const float*)(c.ws + WS_BCUM); const float* CHS = (const float*)(c.ws + WS_CHS);
    float* WINT = (float*)(c.ws + WS_WINT); float* ENEG = (float*)(c.ws + WS_ENEG); float* DENI = (float*)(c.ws + WS_DENI);
    const float scale = 0.08838834764831845f;
    int it = 0;
    for (int ch = blockIdx.x; ch < 2048; ch += c.G, ++it) {
        LAS unsigned char* buf = c.lds + (it & 1) * PR_BUF;
        LAS unsigned short* vT = (LAS unsigned short*)(buf + PR_VT); LAS unsigned short* kT = (LAS unsigned short*)(buf + PR_KW);
        LAS float* las = (LAS float*)(buf + PR_AS); LAS float* lbt = (LAS float*)(buf + PR_BT);
        const int bh = ch >> 7, j = ch & 127, b = bh >> 2, h = bh & 3; const int row0 = b * SEQ + 64 * j;
        const float Mprev = CHS[ch], Mnew = CHS[2048 + ch];
        const int ms = row0 + lane;
        const float bt_l = BCUM[(size_t)ms * 4 + h], i_l = GATES[(size_t)ms * 8 + h];
        s16x8 vx[4], kx[2];
        { const bf16_t* vsrc = PROJ + (size_t)ms * APN + 1024 + h * 256 + 32 * w;
#pragma unroll
          for (int i = 0; i < 4; ++i) vx[i] = *(const s16x8*)(vsrc + 8 * i);
          const bf16_t* ksrc = PROJ + (size_t)ms * APN + 512 + h * 128 + 16 * w;
#pragma unroll
          for (int i = 0; i < 2; ++i) kx[i] = *(const s16x8*)(ksrc + 8 * i); }
        __builtin_amdgcn_sched_barrier(0);
        s16x8 kf[4][4], qf[4];
        { const bf16_t* kb = PROJ + (size_t)(row0 + cc) * APN + 512 + h * 128 + 8 * g;
#pragma unroll
          for (int Ts = 0; Ts < 4; ++Ts)
#pragma unroll
              for (int kk = 0; kk < 4; ++kk) kf[Ts][kk] = *(const s16x8*)(kb + (size_t)16 * Ts * APN + 32 * kk);
          const bf16_t* qb = PROJ + (size_t)(row0 + 16 * Tt + cc) * APN + h * 128 + 8 * g;
#pragma unroll
          for (int kk = 0; kk < 4; ++kk) qf[kk] = *(const s16x8*)(qb + 32 * kk); }
        __builtin_amdgcn_sched_barrier(0);
        { const float blast = __shfl(bt_l, 63);
          const float wk_l = fexp(blast - bt_l + i_l - Mnew);
          if (w == 0) { las[lane] = i_l - bt_l; lbt[lane] = bt_l; }
#pragma unroll
          for (int i = 0; i < 4; ++i) {
#pragma unroll
              for (int e = 0; e < 8; ++e) vT[(32 * w + 8 * i + e) * 72 + lane] = (unsigned short)vx[i][e]; }
#pragma unroll
          for (int i = 0; i < 2; ++i) {
#pragma unroll
              for (int e = 0; e < 8; e += 2) { const unsigned pk = cvtpk(bf1((unsigned short)kx[i][e]) * wk_l, bf1((unsigned short)kx[i][e + 1]) * wk_l);
                  kT[(16 * w + 8 * i + e) * 72 + lane] = (unsigned short)(pk & 0xffffu); kT[(16 * w + 8 * i + e + 1) * 72 + lane] = (unsigned short)(pk >> 16); } } }
        __builtin_amdgcn_sched_barrier(0);
        asm volatile("s_waitcnt lgkmcnt(0)" ::: "memory"); __builtin_amdgcn_s_barrier(); asm volatile("" ::: "memory");
        f32x4 st[4];
#pragma unroll
        for (int Ts = 0; Ts < 4; ++Ts) { st[Ts] = (f32x4){0.f, 0.f, 0.f, 0.f};
#pragma unroll
            for (int kk = 0; kk < 4; ++kk) st[Ts] = MFMA16(kf[Ts][kk], qf[kk], st[Ts]); }
        const int t = 16 * Tt + cc; const float btt = lbt[t];
        f32x4 dd[4]; float dmax = -INFINITY;
#pragma unroll
        for (int Ts = 0; Ts < 4; ++Ts) { const f32x4 av = *(const LAS f32x4*)(las + 16 * Ts + 4 * g);
#pragma unroll
            for (int jj = 0; jj < 4; ++jj) { const int s = 16 * Ts + 4 * g + jj; const float d = btt + av[jj]; dd[Ts][jj] = d; if (s <= t) dmax = fmaxf(dmax, d); } }
        dmax = fmaxf(dmax, __shfl_xor(dmax, 16)); dmax = fmaxf(dmax, __shfl_xor(dmax, 32));
        const float mt = fmaxf(btt + Mprev, dmax);
        float psum = 0.f; f32x4 p[4];
#pragma unroll
        for (int Ts = 0; Ts < 4; ++Ts)
#pragma unroll
            for (int jj = 0; jj < 4; ++jj) { const int s = 16 * Ts + 4 * g + jj; const float pv = (s <= t) ? fexp(dd[Ts][jj] - mt) * st[Ts][jj] * scale : 0.f; p[Ts][jj] = pv; psum += pv; }
        psum += __shfl_xor(psum, 16); psum += __shfl_xor(psum, 32);
        const s16x8 pb0 = pack8(p[0], p[1]), pb1 = pack8(p[2], p[3]);
        bf16_t* nrow = (bf16_t*)NUM + (size_t)(row0 + t) * DM + h * 256 + 128 * dvh + 4 * g;
#pragma unroll
        for (int Td = 0; Td < 8; ++Td) {
            const LAS unsigned short* vr = vT + (128 * dvh + 16 * Td + cc) * 72 + 4 * g;
            const s16x8 a0 = cat4(*(const LAS s16x4*)(vr), *(const LAS s16x4*)(vr + 16));
            const s16x8 a1 = cat4(*(const LAS s16x4*)(vr + 32), *(const LAS s16x4*)(vr + 48));
            f32x4 o = (f32x4){0.f, 0.f, 0.f, 0.f};
            o = MFMA16(a0, pb0, o); o = MFMA16(a1, pb1, o);
            { u32x2 ow; ow.x = cvtpk(o[0], o[1]); ow.y = cvtpk(o[2], o[3]); *(u32x2*)(nrow + 16 * Td) = ow; }
        }
        if (dvh == 0 && g == 0) { const size_t ix = (size_t)(row0 + t) * 4 + h; WINT[ix] = fexp(btt + Mprev - mt) * scale; ENEG[ix] = fexp(-mt); DENI[ix] = psum; }
#pragma unroll
        for (int i = 0; i < 4; ++i) { const int pi = tid + 512 * i; *(s16x8*)(VT + (size_t)ch * (272 * 64) + (size_t)pi * 8) = *(const LAS s16x8*)(buf + PR_VT + (pi >> 3) * 144 + (pi & 7) * 16); }
#pragma unroll
        for (int i = 0; i < 2; ++i) { const int pi = tid + 512 * i; *(s16x8*)(KWT + (size_t)ch * 8192 + (size_t)pi * 8) = *(const LAS s16x8*)(buf + PR_KW + (pi >> 3) * 144 + (pi & 7) * 16); }
        if (tid < 128) { const short ov = (tid < 8) ? (short)0x3F80 : (short)0; const s16x8 o8 = {ov, ov, ov, ov, ov, ov, ov, ov}; *(s16x8*)(VT + (size_t)ch * (272 * 64) + (size_t)(2048 + tid) * 8) = o8; }
    }
}

constexpr int SQ_KWO = 0, SQ_QO = 16384, SQ_VTO = 32768, SQ_WO = 36864, SQ_STG = 37888, SQ_DEC = 3 * SQ_STG;
__device__ __forceinline__ void mlstm_seq(const Ctx& c, const Args& a) {
    int bh, sp;
    if (c.G == 256) { const int x = blockIdx.x & 7, li = blockIdx.x >> 3; if (li >= 18) { p0_weights(c, a, 1, (li - 18) * 8 + x, 112); return; } bh = 2 * x + li / 9; sp = li % 9; }
    else { if ((int)blockIdx.x >= 144) return; bh = blockIdx.x / 9; sp = blockIdx.x % 9; }
    const int tid = c.tid, lane = c.lane, w = c.wave, g = lane >> 4, cc = lane & 15, si = w >> 2, Tt = w & 3, sl = 2 * sp + si, b = bh >> 2, h = bh & 3;
    const bool active = sl < 17;
    const bf16_t* PROJ = (const bf16_t*)(c.ws + WS_PROJ); const bf16_t* KWT = (const bf16_t*)(c.ws + WS_KWT); const bf16_t* VT = (const bf16_t*)(c.ws + WS_VT);
    const float* CHS = (const float*)(c.ws + WS_CHS); const float* WINT = (const float*)(c.ws + WS_WINT); float* DEN = (float*)(c.ws + WS_DEN); bf16_t* INTER = (bf16_t*)(c.ws + WS_HN);
    unsigned kwoff[2], qoff[2], xoff; const bool isv = w < 4;
#pragma unroll
    for (int i = 0; i < 2; ++i) { const int I = 2 * w + i; const int row = 8 * I + (lane >> 3); kwoff[i] = (unsigned)(row * 64 + 8 * ((lane & 7) ^ (row & 7)));
        const int t = 4 * I + (lane >> 4); qoff[i] = (unsigned)(t * APN + h * 128 + 8 * ((lane & 15) ^ (t & 15))); }
    { const int rr = 8 * (w & 3) + (lane >> 3); int slc = 2 * sp + (rr >> 4); if (slc > 16) slc = 16;
      xoff = isv ? (unsigned)((16 * slc + (rr & 15)) * 64 + 8 * ((lane & 7) ^ (rr & 7))) : (unsigned)(lane * 4); }
#define SQ_DMA(k) do { const unsigned ch_ = (unsigned)(bh * 128 + (k)); const size_t row0_ = (size_t)(b * SEQ + 64 * (k)); LAS unsigned char* sb_ = c.lds + ((k) % 3) * SQ_STG; \
        __builtin_amdgcn_global_load_lds((const unsigned*)(KWT + (size_t)ch_ * 8192 + kwoff[0]), (LAS unsigned*)(sb_ + SQ_KWO + (2 * w) * 1024), 16, 0, 0); \
        __builtin_amdgcn_global_load_lds((const unsigned*)(KWT + (size_t)ch_ * 8192 + kwoff[1]), (LAS unsigned*)(sb_ + SQ_KWO + (2 * w + 1) * 1024), 16, 0, 0); \
        __builtin_amdgcn_global_load_lds((const unsigned*)(PROJ + row0_ * APN + qoff[0]), (LAS unsigned*)(sb_ + SQ_QO + (2 * w) * 1024), 16, 0, 0); \
        __builtin_amdgcn_global_load_lds((const unsigned*)(PROJ + row0_ * APN + qoff[1]), (LAS unsigned*)(sb_ + SQ_QO + (2 * w + 1) * 1024), 16, 0, 0); \
        const void* xs_ = isv ? (const void*)(VT + (size_t)ch_ * (272 * 64) + xoff) : (const void*)(WINT + row0_ * 4 + xoff); \
        __builtin_amdgcn_global_load_lds((const unsigned*)xs_, (LAS unsigned*)(sb_ + (isv ? SQ_VTO + (w & 3) * 1024 : SQ_WO)), 16, 0, 0); } while (0)
    SQ_DMA(0); SQ_DMA(1);
    LAS float* dectab = (LAS float*)(c.lds + SQ_DEC);
    if (tid < 128) dectab[tid] = CHS[4096 + bh * 128 + tid];
    constexpr int SQ_EX = SQ_DEC + 512;
    { LAS u32x4* ex = (LAS u32x4*)(c.lds + SQ_EX); for (int i = tid; i < 1024; i += 512) ex[i] = (u32x4){0u, 0u, 0u, 0u}; }
    f32x4 C0 = (f32x4){0.f, 0.f, 0.f, 0.f}, C1 = (f32x4){0.f, 0.f, 0.f, 0.f};
    s16x8 aown = (s16x8){0, 0, 0, 0, 0, 0, 0, 0};
    const int qsw = cc, ksw = cc & 7;
#pragma unroll 1
    for (int j = 0; j < 128; ++j) {
        if (j == 127) asm volatile("s_waitcnt vmcnt(0)" ::: "memory"); else if (active && j >= 2) asm volatile("s_waitcnt vmcnt(7)" ::: "memory"); else asm volatile("s_waitcnt vmcnt(5)" ::: "memory");
        asm volatile("s_waitcnt lgkmcnt(0)" ::: "memory"); __builtin_amdgcn_s_barrier(); asm volatile("" ::: "memory");
        if (j + 2 < 128) SQ_DMA(j + 2);
        if (active) {
            const LAS unsigned char* sb_ = c.lds + (j % 3) * SQ_STG; const int row_ = b * SEQ + 64 * j + 16 * Tt + cc;
            const LAS unsigned char* exr_ = c.lds + SQ_EX + (((j + 1) & 1) * 2 + si) * 4096 + lane * 16;
            f32x4 acc_ = (f32x4){0.f, 0.f, 0.f, 0.f}; const LAS unsigned char* qa_ = sb_ + SQ_QO + (16 * Tt + cc) * 256 + 8 * (g & 1);
#pragma unroll
            for (int ks = 0; ks < 4; ++ks) { const s16x8 a_ = (ks == Tt) ? aown : *(const LAS s16x8*)(exr_ + ks * 1024);
                const s16x8 b_ = cat4(*(const LAS s16x4*)(qa_ + (((4 * ks + (g >> 1)) ^ qsw) << 4)), *(const LAS s16x4*)(qa_ + (((4 * ks + 2 + (g >> 1)) ^ qsw) << 4))); acc_ = MFMA16(a_, b_, acc_); }
            const float wv_ = *(const LAS float*)(sb_ + SQ_WO + 16 * (16 * Tt + cc) + 4 * h);
            if (sl < 16) { u32x2 o_; o_.x = cvtpk(acc_[0] * wv_, acc_[1] * wv_); o_.y = cvtpk(acc_[2] * wv_, acc_[3] * wv_); *(u32x2*)(INTER + (size_t)row_ * DM + h * 256 + 16 * sl + 4 * g) = o_; }
            else if (g == 0) DEN[(size_t)row_ * 4 + h] = wv_ * acc_[0];
            const float dec_ = dectab[j]; const LAS unsigned char* ka_ = sb_ + SQ_KWO + (32 * Tt + cc) * 128; const LAS unsigned char* va_ = sb_ + SQ_VTO + (si * 16 + cc) * 128;
            const s16x8 v0_ = *(const LAS s16x8*)(va_ + ((g ^ ksw) << 4)), v1_ = *(const LAS s16x8*)(va_ + (((4 + g) ^ ksw) << 4));
            C0 = C0 * dec_; C0 = MFMA16(*(const LAS s16x8*)(ka_ + ((g ^ ksw) << 4)), v0_, C0); C0 = MFMA16(*(const LAS s16x8*)(ka_ + (((4 + g) ^ ksw) << 4)), v1_, C0);
            C1 = C1 * dec_; C1 = MFMA16(*(const LAS s16x8*)(ka_ + 16 * 128 + ((g ^ ksw) << 4)), v0_, C1); C1 = MFMA16(*(const LAS s16x8*)(ka_ + 16 * 128 + (((4 + g) ^ ksw) << 4)), v1_, C1);
            aown = pack8(C0, C1);
            *(LAS s16x8*)(c.lds + SQ_EX + ((j & 1) * 2 + si) * 4096 + Tt * 1024 + lane * 16) = aown;
        }
    }
#undef SQ_DMA
}

__device__ __forceinline__ void mlstm_post(const Ctx& c, const float* NUM, const float* head_norm, bf16_t* OUT) {
    const int gw = blockIdx.x * 8 + c.wave, NGW = c.G * 8, lane = c.lane;
    const bf16_t* PROJ = (const bf16_t*)(c.ws + WS_PROJ); const float* DEN = (const float*)(c.ws + WS_DEN); const float* ENEG = (const float*)(c.ws + WS_ENEG); const float* DENI = (const float*)(c.ws + WS_DENI);
    for (int m = gw; m < M; m += NGW) {
#pragma unroll
        for (int h = 0; h < 4; ++h) {
            const u32x2 iu = *(const u32x2*)(OUT + (size_t)m * DM + h * 256 + 4 * lane);
            const u32x2 nu = *(const u32x2*)((const bf16_t*)NUM + (size_t)m * DM + h * 256 + 4 * lane);
            const f32x4 nv = (f32x4){bflo(nu.x), bfhi(nu.x), bflo(nu.y), bfhi(nu.y)} + (f32x4){bflo(iu.x), bfhi(iu.x), bflo(iu.y), bfhi(iu.y)};
            const float den = DEN[(size_t)m * 4 + h] + DENI[(size_t)m * 4 + h], en = ENEG[(size_t)m * 4 + h];
            const float inv = __builtin_amdgcn_rcpf(fmaxf(fabsf(den), en));
            const f32x4 hv = nv * inv;
            float ss = (hv[0] * hv[0] + hv[1] * hv[1]) + (hv[2] * hv[2] + hv[3] * hv[3]); ss = wave_sum(ss);
            const float rs = __builtin_amdgcn_rsqf(ss * (1.f / 256.f) + EPS);
            const u32x2 ou = *(const u32x2*)(PROJ + (size_t)m * APN + 2048 + h * 256 + 4 * lane);
            const f32x4 op = {bflo(ou.x), bfhi(ou.x), bflo(ou.y), bfhi(ou.y)};
            const f32x4 hn = *(const f32x4*)(head_norm + h * 256 + 4 * lane);
            f32x4 r;
#pragma unroll
            for (int e = 0; e < 4; ++e) r[e] = (hv[e] * rs * hn[e]) * __builtin_amdgcn_rcpf(1.f + __builtin_amdgcn_exp2f(-1.4426950408889634f * op[e]));
            u32x2 wv; wv.x = cvtpk(r[0], r[1]); wv.y = cvtpk(r[2], r[3]);
            *(u32x2*)(OUT + (size_t)m * DM + h * 256 + 4 * lane) = wv;
        }
    }
}

__device__ __forceinline__ void rope_cs(int pos, int jf, float& cs, float& sn) {
    const float inv = exp2f(-(float)jf * (13.287712379549449f / 32.f));
    const float ang = (float)pos * inv;
    double tt = (double)ang * 0.15915494309189535; tt -= floor(tt);
    const float tf = (float)tt;
    sn = __builtin_amdgcn_sinf(tf); cs = __builtin_amdgcn_cosf(tf);
}

__device__ __forceinline__ void mla_prep(const Ctx& c, const Args& a) {
    const int gw = blockIdx.x * 8 + c.wave, NGW = c.G * 8, lane = c.lane;
    const bf16_t* CKV = (const bf16_t*)(c.ws + WS_CKV); const bf16_t* QA = (const bf16_t*)(c.ws + WS_QA);
    bf16_t* CKVN = (bf16_t*)(c.ws + WS_CKVN); bf16_t* QAN = (bf16_t*)(c.ws + WS_QAN); bf16_t* KR = (bf16_t*)(c.ws + WS_KR); float* ROPE = (float*)(c.ws + WS_ROPE);
    const int* positions = (const int*)a.in[2]; const float* kvl = a.in[20]; const float* qn = a.in[13];
    for (int m = gw; m < M; m += NGW) {
        { const u32x2 u = *(const u32x2*)(CKV + (size_t)m * 512 + 4 * lane); const f32x4 v = {bflo(u.x), bfhi(u.x), bflo(u.y), bfhi(u.y)};
          float ss = (v[0] * v[0] + v[1] * v[1]) + (v[2] * v[2] + v[3] * v[3]); ss = wave_sum(ss); const float rs = __builtin_amdgcn_rsqf(ss * (1.f / 256.f) + EPS);
          const f32x4 gn = *(const f32x4*)(kvl + 4 * lane); u32x2 w; w.x = cvtpk(v[0] * rs * gn[0], v[1] * rs * gn[1]); w.y = cvtpk(v[2] * rs * gn[2], v[3] * rs * gn[3]);
          *(u32x2*)(CKVN + (size_t)m * 256 + 4 * lane) = w; }
        if (lane < 32) { const float x1 = bf1(CKV[(size_t)m * 512 + 256 + lane]), x2 = bf1(CKV[(size_t)m * 512 + 288 + lane]); float cs, sn; rope_cs(positions[m], lane, cs, sn);
          ROPE[(size_t)m * 64 + lane] = cs; ROPE[(size_t)m * 64 + 32 + lane] = sn;
          const unsigned pk = cvtpk(x1 * cs - x2 * sn, x1 * sn + x2 * cs); KR[(size_t)m * 64 + lane] = (bf16_t)(pk & 0xffffu); KR[(size_t)m * 64 + 32 + lane] = (bf16_t)(pk >> 16); }
        { const unsigned* qp = (const unsigned*)(QA + (size_t)m * 512 + 6 * lane); const unsigned u0 = qp[0], u1 = qp[1], u2 = qp[2];
          float v[6] = {bflo(u0), bfhi(u0), bflo(u1), bfhi(u1), bflo(u2), bfhi(u2)};
          float ss = 0.f;
#pragma unroll
          for (int e = 0; e < 6; ++e) ss += v[e] * v[e];
          ss = wave_sum(ss); const float rs = __builtin_amdgcn_rsqf(ss * (1.f / 384.f) + EPS);
          const float* gq = qn + 6 * lane; unsigned* op = (unsigned*)(QAN + (size_t)m * 384 + 6 * lane);
          op[0] = cvtpk(v[0] * rs * gq[0], v[1] * rs * gq[1]); op[1] = cvtpk(v[2] * rs * gq[2], v[3] * rs * gq[3]); op[2] = cvtpk(v[4] * rs * gq[4], v[5] * rs * gq[5]); }
    }
}

constexpr int AK_STRIDE = 200, AV_STRIDE = 72, AK_BYTES = 64 * AK_STRIDE * 2, AV_BYTES = 128 * AV_STRIDE * 2, ABUF = AK_BYTES + AV_BYTES;
__device__ __forceinline__ void attn_unit(const Ctx& c, const Args& a, int b, int h, int u) {
    const bf16_t* KV = (const bf16_t*)a.out;
    const int tid = c.tid, lane = c.lane, w = c.wave, r = lane & 31, hi = lane >> 5;
    const bf16_t* Q = (const bf16_t*)(c.ws + WS_Q); const bf16_t* KR = (const bf16_t*)(c.ws + WS_KR); bf16_t* O = (bf16_t*)(c.ws + WS_HN);
    const int rowb = b * SEQ; const int qrow = rowb + 256 * u + 32 * w + r;
    const int nt = 4 * u + 4, lim = 4 * u + (w >> 1);
    const unsigned knoff = (unsigned)((rowb + (tid >> 4)) * 2048 + h * 256 + 8 * (tid & 15));
    const unsigned kroff = (unsigned)((rowb + (tid >> 3)) * 64 + 8 * (tid & 7));
    const unsigned voff = (unsigned)((rowb + 2 * (tid & 31)) * 2048 + h * 256 + 128 + 8 * (tid >> 5));
    const int vkpos = ((2 * (tid & 31)) & ~12) | (((2 * (tid & 31)) & 4) << 1) | (((2 * (tid & 31)) & 8) >> 1);
    s16x8 sk[3], sv[2];
#define ATT_LOAD(kt) do { sk[0] = *(const s16x8*)(KV + knoff + (unsigned)(kt) * (64u * 2048u)); sk[1] = *(const s16x8*)(KV + knoff + 32u * 2048u + (unsigned)(kt) * (64u * 2048u)); \
        sk[2] = *(const s16x8*)(KR + kroff + (unsigned)(kt) * (64u * 64u)); } while (0)
#define ATT_LOADV(kt) do { _Pragma("unroll") for (int i_ = 0; i_ < 2; ++i_) sv[i_] = *(const s16x8*)(KV + voff + 2048 * i_ + (unsigned)(kt) * (64u * 2048u)); } while (0)
#define ATT_STORE(bufo) do { *(LAS s16x8*)(c.lds + (bufo) + ((tid >> 4) * AK_STRIDE + 8 * (tid & 15)) * 2) = sk[0]; *(LAS s16x8*)(c.lds + (bufo) + (((tid >> 4) + 32) * AK_STRIDE + 8 * (tid & 15)) * 2) = sk[1]; \
        *(LAS s16x8*)(c.lds + (bufo) + ((tid >> 3) * AK_STRIDE + 128 + 8 * (tid & 7)) * 2) = sk[2]; \
        _Pragma("unroll") for (int e_ = 0; e_ < 8; ++e_) *(LAS unsigned*)(c.lds + (bufo) + AK_BYTES + ((8 * (tid >> 5) + e_) * AV_STRIDE + vkpos) * 2) = (unsigned)(unsigned short)sv[0][e_] | ((unsigned)(unsigned short)sv[1][e_] << 16); } while (0)
    ATT_LOAD(0); ATT_LOADV(0);
    s16x8 qf[12];
    { const bf16_t* qp = Q + (size_t)qrow * 1536 + h * 192 + 8 * hi;
#pragma unroll
      for (int kk = 0; kk < 12; ++kk) qf[kk] = *(const s16x8*)(qp + 16 * kk);
      const float* rp = (const float*)(c.ws + WS_ROPE) + (size_t)qrow * 64 + 8 * hi;
#pragma unroll
      for (int kk = 8; kk < 10; ++kk) {
          const f32x4 ca = *(const f32x4*)(rp + 16 * (kk - 8)), cb = *(const f32x4*)(rp + 16 * (kk - 8) + 4), sa = *(const f32x4*)(rp + 32 + 16 * (kk - 8)), sb = *(const f32x4*)(rp + 32 + 16 * (kk - 8) + 4);
          const float cs8[8] = {ca[0], ca[1], ca[2], ca[3], cb[0], cb[1], cb[2], cb[3]}, sn8[8] = {sa[0], sa[1], sa[2], sa[3], sb[0], sb[1], sb[2], sb[3]};
          u32x4 o1, o2;
#pragma unroll
          for (int e = 0; e < 8; e += 2) {
              const float x1a = bf1((unsigned short)qf[kk][e]), x1b = bf1((unsigned short)qf[kk][e + 1]), x2a = bf1((unsigned short)qf[kk + 2][e]), x2b = bf1((unsigned short)qf[kk + 2][e + 1]);
              o1[e >> 1] = cvtpk(x1a * cs8[e] - x2a * sn8[e], x1b * cs8[e + 1] - x2b * sn8[e + 1]); o2[e >> 1] = cvtpk(x1a * sn8[e] + x2a * cs8[e], x1b * sn8[e + 1] + x2b * cs8[e + 1]); }
          qf[kk] = __builtin_bit_cast(s16x8, o1); qf[kk + 2] = __builtin_bit_cast(s16x8, o2);
      } }
    ATT_STORE(0);
    __syncthreads();
    f32x16 o[4];
#pragma unroll
    for (int Td = 0; Td < 4; ++Td)
#pragma unroll
        for (int e = 0; e < 16; ++e) o[Td][e] = 0.f;
    float mrun = -INFINITY, lrun = 0.f;
    const float CS = 0.07216878364870322f * 1.4426950408889634f;
#pragma unroll 1
    for (int kt = 0; kt < nt; ++kt) {
        const int bufo = (kt & 1) * ABUF, nbufo = ((kt + 1) & 1) * ABUF;
        if (kt + 1 < nt) { ATT_LOAD(kt + 1); if (kt > lim) ATT_LOADV(kt + 1); }
        if (kt <= lim) {
            f32x16 s0, s1;
#pragma unroll
            for (int e = 0; e < 16; ++e) { s0[e] = 0.f; s1[e] = 0.f; }
            const LAS unsigned char* kb = c.lds + bufo + (r * AK_STRIDE + 8 * hi) * 2;
            __builtin_amdgcn_s_setprio(1);
#pragma unroll
            for (int kk = 0; kk < 12; ++kk) { const s16x8 k0 = *(const LAS s16x8*)(kb + 32 * kk), k1 = *(const LAS s16x8*)(kb + 32 * AK_STRIDE * 2 + 32 * kk);
                s0 = MFMA32(k0, qf[kk], s0); s1 = MFMA32(k1, qf[kk], s1); }
            __builtin_amdgcn_s_setprio(0);
            float mx = s0[0];
#pragma unroll
            for (int e = 0; e < 16; ++e) { mx = fmaxf(mx, s0[e]); mx = fmaxf(mx, s1[e]); }
            mx = fmaxf(mx, __shfl_xor(mx, 32));
            const float mxs = mx * CS;
            if (__any(mxs - mrun > 8.f)) {
                const float mnew = fmaxf(mrun, mxs);
                const float alpha = __builtin_amdgcn_exp2f(mrun - mnew);
                mrun = mnew; lrun *= alpha;
#pragma unroll
                for (int Td = 0; Td < 4; ++Td)
#pragma unroll
                    for (int e = 0; e < 16; ++e) o[Td][e] *= alpha;
            }
            float ps = 0.f;
#pragma unroll
            for (int e = 0; e < 16; ++e) { s0[e] = __builtin_amdgcn_exp2f(s0[e] * CS - mrun); s1[e] = __builtin_amdgcn_exp2f(s1[e] * CS - mrun); ps += s0[e] + s1[e]; }
            lrun += ps;
            s16x8 pb[4];
            { u32x4 t0, t1, t2, t3;
#pragma unroll
              for (int e = 0; e < 4; ++e) { t0[e] = cvtpk(s0[2 * e], s0[2 * e + 1]); t1[e] = cvtpk(s0[8 + 2 * e], s0[8 + 2 * e + 1]); t2[e] = cvtpk(s1[2 * e], s1[2 * e + 1]); t3[e] = cvtpk(s1[8 + 2 * e], s1[8 + 2 * e + 1]); }
              pb[0] = __builtin_bit_cast(s16x8, t0); pb[1] = __builtin_bit_cast(s16x8, t1); pb[2] = __builtin_bit_cast(s16x8, t2); pb[3] = __builtin_bit_cast(s16x8, t3); }
            if (kt + 1 < nt) ATT_LOADV(kt + 1);
            const LAS unsigned char* vb = c.lds + bufo + AK_BYTES + (r * AV_STRIDE + 8 * hi) * 2;
            __builtin_amdgcn_s_setprio(1);
#pragma unroll
            for (int Td = 0; Td < 4; ++Td)
#pragma unroll
                for (int q2 = 0; q2 < 4; ++q2) {
                    const LAS unsigned char* vp = vb + (32 * Td * AV_STRIDE + 16 * q2) * 2;
                    const s16x8 av = *(const LAS s16x8*)(vp);
                    o[Td] = MFMA32(av, pb[q2], o[Td]); }
        }
        __builtin_amdgcn_s_setprio(0);
        if (kt + 1 < nt) ATT_STORE(nbufo);
        __syncthreads();
    }
    const float ltot = lrun + __shfl_xor(lrun, 32);
    const float inv = 1.f / ltot;
    bf16_t* op = O + (size_t)qrow * DM + h * 128 + 8 * hi;
#pragma unroll
    for (int Td = 0; Td < 4; ++Td)
#pragma unroll
        for (int p = 0; p < 2; ++p) {
            const unsigned x0 = cvtpk(o[Td][8 * p] * inv, o[Td][8 * p + 1] * inv), x1 = cvtpk(o[Td][8 * p + 2] * inv, o[Td][8 * p + 3] * inv);
            const unsigned y0 = cvtpk(o[Td][8 * p + 4] * inv, o[Td][8 * p + 5] * inv), y1 = cvtpk(o[Td][8 * p + 6] * inv, o[Td][8 * p + 7] * inv);
            const auto s0 = __builtin_amdgcn_permlane32_swap(x0, y0, false, false), s1 = __builtin_amdgcn_permlane32_swap(x1, y1, false, false);
            u32x4 wv; wv.x = s0[0]; wv.y = s1[0]; wv.z = s0[1]; wv.w = s1[1];
            *(u32x4*)(op + 32 * Td + 16 * p) = wv; }
#undef ATT_LOAD
#undef ATT_LOADV
#undef ATT_STORE
}
__device__ __forceinline__ void attn_phase(const Ctx& c, const Args& a) {
    const int bx = blockIdx.x; const int vcu = (c.G % 8 == 0) ? (bx % 8) * (c.G / 8) + bx / 8 : bx;
    for (int p = vcu; p < 512; p += c.G) {
        const int bh = p >> 4, u = p & 15, b = bh >> 3, h = bh & 7;
        attn_unit(c, a, b, h, 31 - u);
        attn_unit(c, a, b, h, u);
    }
}

#define XB_TMO      128
#define XB_XCNT(j)  (256  + 64 * (j))
#define XB_XSUB(j)  (1280 + 64 * (j))
#define XB_XGEN(j)  (2304 + 64 * (j))
#define XB_TOP      3328
#define XB_TOPGEN   3392
#define XCD_BAR_WORDS 3456
#define XB_SPIN_CAP (1u << 18)

__device__ __forceinline__ unsigned xb_ld(unsigned* p)              { return __hip_atomic_load(p, __ATOMIC_RELAXED, __HIP_MEMORY_SCOPE_AGENT); }
__device__ __forceinline__ unsigned xb_add(unsigned* p, unsigned v) { return __hip_atomic_fetch_add(p, v, __ATOMIC_RELAXED, __HIP_MEMORY_SCOPE_AGENT); }
__device__ __forceinline__ unsigned xb_xcc_id() { return (unsigned)__builtin_amdgcn_s_getreg((3 << 11) | 20) & 0xFu; }
#define XB_SPIN(cond, bar) do { unsigned _sp = 0; while (cond) { __builtin_amdgcn_s_sleep(1); \
    if ((++_sp & 255u) == 0u) { if (xb_ld(&(bar)[XB_TMO])) break; if (_sp > XB_SPIN_CAP) { atomicAdd(&(bar)[XB_TMO], 1u); break; } } } } while (0)

struct XcdBarrier {
    unsigned* bar; unsigned x;
    volatile LAS unsigned* st;
};

__device__ __forceinline__ XcdBarrier xcd_barrier_post(unsigned* bar, volatile LAS unsigned* st) {
    XcdBarrier b; b.bar = bar; b.x = xb_xcc_id(); b.st = st;
    if (threadIdx.x == 0) (void)xb_add(&bar[XB_XCNT(b.x)], 1u);
    return b;
}
__device__ __forceinline__ void xcd_barrier_complete(unsigned* bar, unsigned x, unsigned& nloc, unsigned& nx) {
    const unsigned G = gridDim.x * gridDim.y * gridDim.z;
    unsigned sum, cnt, mine, sp = 0u;
    for (;;) {
        sum = 0u; cnt = 0u; mine = 0u;
#pragma unroll
        for (unsigned j = 0; j < 16; ++j) { const unsigned c = xb_ld(&bar[XB_XCNT(j)]); sum += c; cnt += (c > 0u) ? 1u : 0u; mine = (j == x) ? c : mine; }
        if (sum == G) break;
        __builtin_amdgcn_s_sleep(1);
        if ((++sp & 255u) == 0u) { if (xb_ld(&bar[XB_TMO])) break; if (sp > XB_SPIN_CAP) { atomicAdd(&bar[XB_TMO], 1u); break; } }
    }
    nloc = mine > 0u ? mine : 1u; nx = cnt > 0u ? cnt : 1u;
}

__device__ __forceinline__ void xcd_barrier(const XcdBarrier& b) {
    asm volatile("s_waitcnt vmcnt(0)" ::: "memory");
    __syncthreads();
    if (threadIdx.x == 0) {
        unsigned* bar = b.bar;
        __builtin_amdgcn_s_waitcnt(0);
        unsigned nloc = b.st[0], nx = b.st[1];
        if (nloc == 0u) { xcd_barrier_complete(bar, b.x, nloc, nx); b.st[0] = nloc; b.st[1] = nx; }
        const unsigned old = xb_add(&bar[XB_XSUB(b.x)], 1u);
        const unsigned gen = old / nloc;
        if (old + 1u == (gen + 1u) * nloc) {
            __builtin_amdgcn_fence(__ATOMIC_RELEASE, "agent");
            asm volatile("s_waitcnt vmcnt(0)" ::: "memory");
            const unsigned og = xb_add(&bar[XB_TOP], 1u);
            const unsigned tg = og / nx;
            if (og + 1u == (tg + 1u) * nx) xb_add(&bar[XB_TOPGEN], 1u);
            else XB_SPIN(xb_ld(&bar[XB_TOPGEN]) == tg, bar);
            __builtin_amdgcn_fence(__ATOMIC_ACQUIRE, "agent");
            xb_add(&bar[XB_XGEN(b.x)], 1u);
            asm volatile("s_waitcnt vmcnt(0)" ::: "memory");
        } else {
            XB_SPIN(xb_ld(&bar[XB_XGEN(b.x)]) == gen, bar);
            __builtin_amdgcn_fence(__ATOMIC_ACQUIRE, "agent");
            asm volatile("s_waitcnt vmcnt(0)" ::: "memory");
        }
    }
    __syncthreads();
}

template <int ACT>
__device__ __forceinline__ void run_gemm(const Ctx& c, const bf16_t* A, const bf16_t* Bt, int N, int K, bf16_t* Out) {
    pg8::Gemm g{A, Bt, M, N, K}; pg8::StaticOrder S; S.init(M, N, c.G, (int)blockIdx.x);
    pg8::EpiBf16<ACT> E{Out, N, nullptr, 0, 0, 1.f};
    pg8::gemm_phase<pg8::EpiBf16<ACT>, pg8::StaticOrder, true, true>(c.lds, g, S, E);
}

__global__ void __launch_bounds__(512, 2) yoco_fwd(Args a) {
    extern __shared__ __attribute__((aligned(16))) unsigned char lds_raw[];
    cg::grid_group grid = cg::this_grid();
#define c mkctx(lds_raw, a.ws)
    unsigned char* ws = a.ws;
    const float* MODS = (const float*)(ws + WS_MODS);
    const float* M0 = MODS; const float* M1 = MODS + 4 * 6144; const float* MKV = MODS + 49152;
    const float* ng = a.in[5];
    bf16_t* HN = (bf16_t*)(ws + WS_HN); bf16_t* Yb = (bf16_t*)(ws + WS_Y); bf16_t* H1 = (bf16_t*)(ws + WS_H1); bf16_t* PROJ = (bf16_t*)(ws + WS_PROJ);
    float* X = a.out; bf16_t* XB = (bf16_t*)(ws + WS_XB);
    if (threadIdx.x < 64) ((LAS unsigned*)((LAS unsigned char*)lds_raw + 131072))[threadIdx.x] = 0u;
    __syncthreads();
    XcdBarrier xbar = xcd_barrier_post((unsigned*)ws, (volatile LAS unsigned*)((LAS unsigned char*)lds_raw + 131072));
#define GSYNC() xcd_barrier(xbar)
    grid.sync();
    p0_prologue(c, a); GSYNC();
    normpass<false, 0, 0, 1, true>(c, a.in[0], nullptr, nullptr, 0, nullptr, nullptr, HN, ng + 0, M0 + 0, M0 + 1024, 6144, nullptr, nullptr, nullptr, nullptr, 0,
                                    a.in[8], a.in[9], (float*)(ws + WS_GATES));
    GSYNC();
    gate_scan(c);
    run_gemm<0>(c, HN, (const bf16_t*)(ws + WS_WIN), APN, 1024, PROJ);
    GSYNC();
    mlstm_pre(c, X); GSYNC();
    mlstm_seq(c, a); GSYNC();
    mlstm_post(c, X, a.in[10], HN); GSYNC();
    run_gemm<0>(c, HN, (const bf16_t*)(ws + WS_WOUT), 1024, 1024, Yb); GSYNC();
    normpass<true, 0, 2, 1, false>(c, a.in[0], Yb, M0 + 2048, 6144, ng + 1024, XB, HN, ng + 2048, M0 + 3072, M0 + 4096, 6144, nullptr, nullptr, nullptr, nullptr, 0, nullptr, nullptr, nullptr);
    GSYNC();
    run_gemm<2>(c, HN, (const bf16_t*)(ws + WS_W1A), DFF, 1024, H1); GSYNC();
    run_gemm<0>(c, H1, (const bf16_t*)(ws + WS_W2A), 1024, DFF, Yb); GSYNC();
    normpass<true, 1, 2, 2, false>(c, XB, Yb, M0 + 5120, 6144, ng + 3072, XB, HN, ng + 4096, M1 + 0, M1 + 1024, 6144, (bf16_t*)(ws + WS_HNKV), a.in[18], MKV + 0, MKV + 1024, 2048,
                                   nullptr, nullptr, nullptr);
    GSYNC();
    run_gemm<0>(c, (const bf16_t*)(ws + WS_HNKV), (const bf16_t*)(ws + WS_WDKV), 512, 1024, (bf16_t*)(ws + WS_CKV));
    run_gemm<0>(c, HN, (const bf16_t*)(ws + WS_WQA), 512, 1024, (bf16_t*)(ws + WS_QA));
    GSYNC();
    mla_prep(c, a); GSYNC();
    run_gemm<0>(c, (const bf16_t*)(ws + WS_CKVN), (const bf16_t*)(ws + WS_WUKV), 2048, 256, (bf16_t*)a.out);
    run_gemm<0>(c, (const bf16_t*)(ws + WS_QAN), (const bf16_t*)(ws + WS_WQB), 1536, 384, (bf16_t*)(ws + WS_Q));
    GSYNC();
    attn_phase(c, a); GSYNC();
    run_gemm<0>(c, HN, (const bf16_t*)(ws + WS_WO), 1024, 1024, Yb); GSYNC();
    normpass<true, 1, 2, 1, false>(c, XB, Yb, M1 + 2048, 6144, ng + 4096 + 1024, XB, HN, ng + 4096 + 2048, M1 + 3072, M1 + 4096, 6144, nullptr, nullptr, nullptr, nullptr, 0, nullptr, nullptr, nullptr);
    GSYNC();
    run_gemm<2>(c, HN, (const bf16_t*)(ws + WS_W1B), DFF, 1024, H1); GSYNC();
    run_gemm<0>(c, H1, (const bf16_t*)(ws + WS_W2B), 1024, DFF, Yb); GSYNC();
    normpass<true, 1, 1, 0, false>(c, XB, Yb, M1 + 5120, 6144, ng + 4096 + 3072, X, nullptr, nullptr, nullptr, nullptr, 0, nullptr, nullptr, nullptr, nullptr, 0, nullptr, nullptr, nullptr);
#undef c
}
}

extern "C" void kernel_launch(void* const* d_in, const int* in_sizes, int n_in, void* d_out, int out_size, void* d_ws, size_t ws_size, hipStream_t stream) {
    static int grid = 0;
    if (grid == 0) {
        if (n_in != 22 || out_size != mk::M * mk::DM || ws_size < mk::WS_END) { fprintf(stderr, "kernel_launch: unexpected shapes (n_in %d out %d ws %zu)\n", n_in, out_size, ws_size); grid = -1; return; }
        int dev = 0, cus = 0, per_cu = 0;
        hipGetDevice(&dev); hipDeviceGetAttribute(&cus, hipDeviceAttributeMultiprocessorCount, dev);
        hipFuncSetAttribute((const void*)mk::yoco_fwd, hipFuncAttributeMaxDynamicSharedMemorySize, mk::LDS_BYTES);
        hipOccupancyMaxActiveBlocksPerMultiprocessor(&per_cu, (const void*)mk::yoco_fwd, 512, mk::LDS_BYTES);
        if (per_cu < 1) per_cu = 1;
        grid = cus * 1;
        (void)hipGetLastError();
    }
    if (grid < 0) return;
    mk::Args a{};
    for (int i = 0; i < 22; ++i) a.in[i] = (const float*)d_in[i];
    a.out = (float*)d_out; a.ws = (unsigned char*)d_ws;
    void* args[] = {&a};
    if (hipMemsetAsync(d_ws, 0, 65536, stream) != hipSuccess) { fprintf(stderr, "kernel_launch: memset of the barrier words failed\n"); return; }
    hipError_t e = hipLaunchCooperativeKernel((const void*)mk::yoco_fwd, dim3(grid), dim3(512), args, mk::LDS_BYTES, stream);
    if (e != hipSuccess) fprintf(stderr, "cooperative launch failed: %s (grid %d)\n", hipGetErrorString(e), grid);
}
```

```cpp
#include <hip/hip_runtime.h>
#include <hip/hip_bf16.h>
#include <cmath>
#include <cstdio>
#include <cstdint>
namespace pg8 {
#define PG8_LAS __attribute__((address_space(3)))
typedef unsigned short bf16_t;
typedef short bf16x8 __attribute__((ext_vector_type(8)));
typedef float f32x4 __attribute__((ext_vector_type(4)));
typedef unsigned u32x4 __attribute__((ext_vector_type(4)));
constexpr int BM = 256, BK = 64, HALF = 128, HTB = HALF * BK * 2  , STAGE_BYTES = 8 * HTB, NXCD = 8, WGM = 8;

__host__ __device__ __forceinline__ int lds_byte(int r, int c) { const int st = (r >> 4) * 2 + (c >> 5), rr = r & 15, cc = c & 31, ob = rr * 64 + cc * 2; return st * 1024 + (ob ^ (((ob >> 9) & 1) << 5)); }
__host__ __device__ __forceinline__ void stage_rc(int b, int& R, int& C) { const int st = b / 1024, sb = b % 1024, swz = sb ^ (((sb >> 9) & 1) << 5); R = (st >> 1) * 16 + swz / 64; C = (st & 1) * 32 + (swz % 64) / 2; }
__host__ __device__ __forceinline__ int perm32(int rho) { const int n = rho >> 4, i = rho & 15; return 8 * (i >> 2) + 4 * n + (i & 3); }

struct Unit { int pm, pn; };
struct Gemm { const bf16_t* A; const bf16_t* Bt; int M, N, K; };

struct StaticOrder {
    int nM, nN, nwg, G, c;
    __host__ __device__ void init(int M, int N, int G_, int c_) { nM = M / BM; nN = N / BM; nwg = nM * nN; G = G_; c = c_; }
    __host__ __device__ bool next(int i, Unit& u) const {
        const long L = (long)i * G + c; if (L >= nwg) return false;
        int wgid = (int)L; { const int q = nwg / NXCD, r = nwg % NXCD, xcd = wgid % NXCD, off = wgid / NXCD; wgid = (xcd < r ? xcd * (q + 1) : r * (q + 1) + (xcd - r) * q) + off; }
        const int nig = WGM * nN, gid = wgid / nig, fm = gid * WGM, gsz = (nM - fm) < WGM ? (nM - fm) : WGM;
        u.pm = fm + ((wgid % nig) % gsz); u.pn = (wgid % nig) / gsz; return true;
    }
    __device__ __forceinline__ void a_ready(const Unit&) const {}
    __device__ __forceinline__ void done(const Unit&) const {}
};

__device__ __forceinline__ unsigned cvt_pk_bf16(float lo, float hi) { unsigned r; asm volatile("v_cvt_pk_bf16_f32 %0, %1, %2" : "=v"(r) : "v"(lo), "v"(hi)); return r; }
typedef float f32x2 __attribute__((ext_vector_type(2)));
__device__ __forceinline__ f32x2 gelu_pk(f32x2 v) {
    const f32x2 av = __builtin_elementwise_abs(v), d = av * 0.2316418882f + 1.0f;
    f32x2 t; t.x = __builtin_amdgcn_rcpf(d.x); t.y = __builtin_amdgcn_rcpf(d.y);
    f32x2 q = t * 0.5307027145f + (-0.7265760135f); q = q * t + 0.7107068705f; q = q * t + (-0.142248368f); q = q * t + 0.127414796f; q = q * t;
    const f32x2 s = (v * v) * (-0.72134752044f);
    f32x2 e; e.x = __builtin_amdgcn_exp2f(s.x); e.y = __builtin_amdgcn_exp2f(s.y);
    const f32x2 m = v * (q * e), r = v - m;
    f32x2 o; o.x = v.x < 0.f ? m.x : r.x; o.y = v.y < 0.f ? m.y : r.y; return o;
}

template <int ACT  > struct EpiBf16 {
    static constexpr bool PERM = true, AFTER_DRAIN = false; static_assert(ACT == 0 || ACT == 1 || ACT == 2, "EpiBf16: ACT is 0 (none), 1 (gelu_pk) or 2 (squared relu)");
    bf16_t* O; int ldc; const float* bias; int split_cols; size_t split_stride; float scale0;
    __device__ __forceinline__ void operator()(const f32x4 (&acc)[2][2][4][2], const Unit& u, int wr, int wc, int fr, int fq) const {
        const int row0 = u.pm * BM + wr * 64 + fr; int colt = u.pn * BM; bf16_t* base = O;
        float sc = 1.f; if (split_cols) { const int t = colt / split_cols; base += (size_t)t * split_stride; colt -= t * split_cols; if (t == 0) sc = scale0; }
        const int col0 = colt + wc * 32 + 8 * fq, bcol0 = u.pn * BM + wc * 32 + 8 * fq;
        f32x4 bv[2][2];
#pragma unroll
        for (int bj = 0; bj < 2; ++bj)
#pragma unroll
            for (int n = 0; n < 2; ++n) bv[bj][n] = bias ? *(const f32x4*)(bias + bcol0 + bj * HALF + 4 * n) : (f32x4){0.f, 0.f, 0.f, 0.f};
#pragma unroll
        for (int ai = 0; ai < 2; ++ai)
#pragma unroll
            for (int m = 0; m < 4; ++m) { bf16_t* rowp = base + (size_t)(row0 + ai * HALF + m * 16) * ldc + col0;
#pragma unroll
                for (int bj = 0; bj < 2; ++bj) { f32x4 v0 = acc[ai][bj][m][0] + bv[bj][0], v1 = acc[ai][bj][m][1] + bv[bj][1];
                    if (ACT == 1) { f32x2 a = gelu_pk((f32x2){v0[0], v0[1]}), b = gelu_pk((f32x2){v0[2], v0[3]}), c = gelu_pk((f32x2){v1[0], v1[1]}), d = gelu_pk((f32x2){v1[2], v1[3]});
                        v0 = (f32x4){a.x, a.y, b.x, b.y}; v1 = (f32x4){c.x, c.y, d.x, d.y}; }
                    if (ACT == 2) { const f32x4 z = {0.f, 0.f, 0.f, 0.f}; v0 = __builtin_elementwise_max(v0, z); v1 = __builtin_elementwise_max(v1, z); v0 = v0 * v0; v1 = v1 * v1; }
                    v0 = v0 * sc; v1 = v1 * sc; u32x4 w; w.x = cvt_pk_bf16(v0[0], v0[1]); w.y = cvt_pk_bf16(v0[2], v0[3]); w.z = cvt_pk_bf16(v1[0], v1[1]); w.w = cvt_pk_bf16(v1[2], v1[3]);
                    *(u32x4*)(rowp + bj * HALF) = w; } }
    }
};

template <class Epi, class Sched, bool ALIGN_EPI = false, bool SP2 = false>
__device__ __forceinline__ void gemm_phase(PG8_LAS unsigned char* lds, const Gemm g, const Sched& S, const Epi& E) {
    const int tid = threadIdx.x, wid = __builtin_amdgcn_readfirstlane(tid >> 6), lane = tid & 63, wr = wid >> 2, wc = wid & 3, fr = lane & 15, fq = lane >> 4;
    const int K = g.K, nt = K / BK;
    unsigned voffA[2], voffB[2];
#pragma unroll
    for (int i = 0; i < 2; ++i) { int R, C; stage_rc(tid * 16 + i * 8192, R, C); const int Rb = Epi::PERM ? ((R & ~31) + perm32(R & 31)) : R;
        voffA[i] = (unsigned)(R * K + C) * 2u; voffB[i] = (unsigned)(Rb * K + C) * 2u; }
    const size_t kstep = (size_t)(BK * 2);
    const size_t hstep = (size_t)HALF * K * 2;
    const size_t tstep = 2 * hstep;
    const unsigned ldsw = (unsigned)wid * 1024u;
    const int aoff = lds_byte(wr * 64 + fr, fq * 8), boff = lds_byte(wc * 32 + fr, fq * 8);
#define PG8_SA(b, h) (((b) * 2 + (h)) * HTB)
#define PG8_SB(b, h) ((4 + (b) * 2 + (h)) * HTB)
#define PG8_STAGE(bufoff, gbase, voff) do { _Pragma("unroll") for (int _i = 0; _i < 2; ++_i) \
        __builtin_amdgcn_global_load_lds((const unsigned*)((const char*)(gbase) + (voff)[_i]), (PG8_LAS unsigned*)(lds + (bufoff) + ldsw + _i * 8192), 16, 0, 0); } while (0)
#define PG8_LDA(dst, b, h) do { _Pragma("unroll") for (int m = 0; m < 4; ++m) _Pragma("unroll") for (int k = 0; k < 2; ++k) dst[m][k] = *(const PG8_LAS bf16x8*)(lds + PG8_SA(b, h) + aoff + m * 2048 + k * 1024); } while (0)
#define PG8_LDB(dst, b, h) do { _Pragma("unroll") for (int n = 0; n < 2; ++n) _Pragma("unroll") for (int k = 0; k < 2; ++k) dst[n][k] = *(const PG8_LAS bf16x8*)(lds + PG8_SB(b, h) + boff + n * 2048 + k * 1024); } while (0)
#define PG8_MMA(ai, bj, At, Bt) do { __builtin_amdgcn_s_setprio(1); _Pragma("unroll") for (int m = 0; m < 4; ++m) _Pragma("unroll") for (int n = 0; n < 2; ++n) _Pragma("unroll") for (int k = 0; k < 2; ++k) \
        acc[ai][bj][m][n] = __builtin_amdgcn_mfma_f32_16x16x32_bf16(Bt[n][k], At[m][k], acc[ai][bj][m][n], 0, 0, 0); __builtin_amdgcn_s_setprio(0); } while (0)
#define PG8_WAIT_V(n) asm volatile("s_waitcnt vmcnt(" #n ")" ::: "memory")
#define PG8_WAIT_L(n) asm volatile("s_waitcnt lgkmcnt(" #n ")" ::: "memory")
#define PG8_BAR __builtin_amdgcn_s_barrier()
#define PG8_SCHED __builtin_amdgcn_sched_barrier(0)
    Unit cur, nxt; int ui = 0;
    if (!S.next(0, cur)) return;
    f32x4 acc[2][2][4][2];
#pragma unroll
    for (int a = 0; a < 2; ++a)
#pragma unroll
        for (int b = 0; b < 2; ++b)
#pragma unroll
            for (int m = 0; m < 4; ++m)
#pragma unroll
                for (int n = 0; n < 2; ++n) acc[a][b][m][n] = (f32x4){0.f, 0.f, 0.f, 0.f};
    bf16x8 At[4][2], B0[2][2], B1[2][2];
    const char* cA = (const char*)g.A + (size_t)cur.pm * tstep; const char* cB = (const char*)g.Bt + (size_t)cur.pn * tstep;
    S.a_ready(cur);
    if constexpr (SP2) {
        PG8_STAGE(PG8_SB(0, 0), cB, voffB); PG8_STAGE(PG8_SB(0, 1), cB + hstep, voffB); PG8_STAGE(PG8_SA(0, 0), cA, voffA); PG8_STAGE(PG8_SA(0, 1), cA + hstep, voffA);
        if (wr == 1) PG8_BAR;
        PG8_WAIT_V(2); PG8_BAR;
        PG8_STAGE(PG8_SB(1, 0), cB + kstep, voffB); PG8_STAGE(PG8_SA(1, 0), cA + kstep, voffA); PG8_STAGE(PG8_SB(1, 1), cB + hstep + kstep, voffB);
        PG8_WAIT_V(6); PG8_BAR;
    } else {
        PG8_STAGE(PG8_SB(0, 0), cB, voffB); PG8_STAGE(PG8_SA(0, 0), cA, voffA); PG8_STAGE(PG8_SB(0, 1), cB + hstep, voffB); PG8_STAGE(PG8_SA(0, 1), cA + hstep, voffA);
        if (wr == 1) PG8_BAR;
        PG8_WAIT_V(4); PG8_BAR;
        PG8_STAGE(PG8_SB(1, 0), cB + kstep, voffB); PG8_STAGE(PG8_SA(1, 0), cA + kstep, voffA); PG8_STAGE(PG8_SB(1, 1), cB + hstep + kstep, voffB);
        PG8_WAIT_V(6); PG8_BAR;
    }
    for (;;) {
        const bool has_next = S.next(ui + 1, nxt);
        const char* nA = has_next ? (const char*)g.A + (size_t)nxt.pm * tstep : cA; const char* nB = has_next ? (const char*)g.Bt + (size_t)nxt.pn * tstep : cB;
        for (int t = 0; t < nt; t += 2) {
            const bool last = (t == nt - 2);
            const char* a1 = cA + (size_t)(t + 1) * kstep;
            const char* a2 = last ? nA : cA + (size_t)(t + 2) * kstep; const char* b2 = last ? nB : cB + (size_t)(t + 2) * kstep;
            const char* a3 = a2 + kstep; const char* b3 = b2 + kstep;
            if (last && has_next) S.a_ready(nxt);
            if constexpr (SP2) {
            PG8_LDB(B0, 0, 0); PG8_LDB(B1, 0, 1); PG8_SCHED; PG8_LDA(At, 0, 0); PG8_STAGE(PG8_SA(1, 1), a1 + hstep, voffA);
            PG8_WAIT_V(8); PG8_WAIT_L(0); PG8_BAR; PG8_MMA(0, 0, At, B0); PG8_MMA(0, 1, At, B1); PG8_BAR; PG8_SCHED;
            PG8_LDA(At, 0, 1); PG8_STAGE(PG8_SB(0, 0), b2, voffB); PG8_STAGE(PG8_SB(0, 1), b2 + hstep, voffB); PG8_STAGE(PG8_SA(0, 0), a2, voffA);
            PG8_WAIT_V(8); PG8_WAIT_L(0); PG8_BAR; PG8_MMA(1, 0, At, B0); PG8_MMA(1, 1, At, B1); PG8_BAR; PG8_SCHED;
            PG8_LDB(B0, 1, 0); PG8_LDB(B1, 1, 1); PG8_SCHED; PG8_LDA(At, 1, 0); PG8_STAGE(PG8_SA(0, 1), a2 + hstep, voffA);
            PG8_WAIT_V(8); PG8_WAIT_L(0); PG8_BAR; PG8_MMA(0, 0, At, B0); PG8_MMA(0, 1, At, B1); PG8_BAR; PG8_SCHED;
            PG8_LDA(At, 1, 1); PG8_STAGE(PG8_SB(1, 0), b3, voffB); PG8_STAGE(PG8_SB(1, 1), b3 + hstep, voffB); PG8_STAGE(PG8_SA(1, 0), a3, voffA);
            PG8_WAIT_V(8); PG8_WAIT_L(0); PG8_BAR; PG8_MMA(1, 0, At, B0); PG8_MMA(1, 1, At, B1); PG8_BAR; PG8_SCHED;
            } else {
            PG8_LDB(B0, 0, 0); PG8_SCHED; PG8_LDA(At, 0, 0); PG8_STAGE(PG8_SA(1, 1), a1 + hstep, voffA);
            PG8_WAIT_L(8); PG8_BAR; PG8_WAIT_L(0); PG8_MMA(0, 0, At, B0); PG8_BAR; PG8_SCHED;
            PG8_LDB(B1, 0, 1); PG8_STAGE(PG8_SB(0, 0), b2, voffB);
            PG8_BAR; PG8_WAIT_L(0); PG8_MMA(0, 1, At, B1); PG8_BAR;
            PG8_LDA(At, 0, 1); PG8_STAGE(PG8_SA(0, 0), a2, voffA);
            PG8_BAR; PG8_WAIT_L(0); PG8_MMA(1, 0, At, B0); PG8_BAR; PG8_SCHED;
            PG8_STAGE(PG8_SB(0, 1), b2 + hstep, voffB);
            PG8_WAIT_V(6); PG8_BAR; PG8_MMA(1, 1, At, B1); PG8_BAR;
            PG8_LDB(B0, 1, 0); PG8_SCHED; PG8_LDA(At, 1, 0); PG8_STAGE(PG8_SA(0, 1), a2 + hstep, voffA);
            PG8_WAIT_L(8); PG8_BAR; PG8_WAIT_L(0); PG8_MMA(0, 0, At, B0); PG8_BAR; PG8_SCHED;
            PG8_LDB(B1, 1, 1); PG8_STAGE(PG8_SB(1, 0), b3, voffB);
            PG8_BAR; PG8_WAIT_L(0); PG8_MMA(0, 1, At, B1); PG8_BAR;
            PG8_LDA(At, 1, 1); PG8_STAGE(PG8_SA(1, 0), a3, voffA);
            PG8_BAR; PG8_WAIT_L(0); PG8_MMA(1, 0, At, B0); PG8_BAR; PG8_SCHED;
            PG8_STAGE(PG8_SB(1, 1), b3 + hstep, voffB);
            PG8_WAIT_V(6); PG8_BAR; PG8_MMA(1, 1, At, B1); PG8_BAR;
            }
        }
        if constexpr (ALIGN_EPI) { if (wr == 0) PG8_BAR; }
        if constexpr (!Epi::AFTER_DRAIN) { E(acc, cur, wr, wc, fr, fq); S.done(cur); }
        if (!has_next) break;
#pragma unroll
        for (int a = 0; a < 2; ++a)
#pragma unroll
            for (int b = 0; b < 2; ++b)
#pragma unroll
                for (int m = 0; m < 4; ++m)
#pragma unroll
                    for (int n = 0; n < 2; ++n) acc[a][b][m][n] = (f32x4){0.f, 0.f, 0.f, 0.f};
        cur = nxt; cA = nA; cB = nB; ++ui;
        if constexpr (ALIGN_EPI) { if (wr == 1) PG8_BAR; }
    }
    PG8_WAIT_V(0);
    if constexpr (!ALIGN_EPI) { if (wr == 0) PG8_BAR; }
    PG8_BAR;
    if constexpr (Epi::AFTER_DRAIN) { E.fused(acc, cur, wr, wc, fr, fq, lds, wid, lane); S.done(cur); }
#undef PG8_SA
#undef PG8_SB
#undef PG8_STAGE
#undef PG8_LDA
#undef PG8_LDB
#undef PG8_MMA
#undef PG8_WAIT_V
#undef PG8_WAIT_L
#undef PG8_BAR
#undef PG8_SCHED
}
}


#include <hip/hip_cooperative_groups.h>
namespace cg = cooperative_groups;
namespace mk {
#define LAS __attribute__((address_space(3)))
typedef unsigned short bf16_t;
typedef short s16x8 __attribute__((ext_vector_type(8)));
typedef short s16x4 __attribute__((ext_vector_type(4)));
typedef float f32x4 __attribute__((ext_vector_type(4)));
typedef float f32x2 __attribute__((ext_vector_type(2)));
typedef float f32x16 __attribute__((ext_vector_type(16)));
typedef unsigned u32x4 __attribute__((ext_vector_type(4)));
typedef unsigned u32x2 __attribute__((ext_vector_type(2)));
typedef __bf16 bf16x2_t __attribute__((ext_vector_type(2)));

constexpr int NB = 4, SEQ = 8192, DM = 1024, M = NB * SEQ, DFF = 4096;
constexpr int APN = 3072, APROJ = 3080;
constexpr float EPS = 1e-6f;
constexpr size_t MiB = 1u << 20;
constexpr size_t WS_MODS = 1 * MiB, WS_GATES = 2 * MiB, WS_BCUM = 3 * MiB, WS_WINT = 3 * MiB + 512 * 1024, WS_ENEG = 4 * MiB, WS_DENI = 4 * MiB + 512 * 1024, WS_DEN = 5 * MiB,
                 WS_CHS = 5 * MiB + 512 * 1024;
constexpr size_t WS_WIN = 8 * MiB, WS_WOUT = 14 * MiB, WS_W1A = 16 * MiB, WS_W2A = 24 * MiB, WS_W1B = 32 * MiB, WS_W2B = 40 * MiB, WS_WQA = 48 * MiB, WS_WDKV = 49 * MiB,
                 WS_WQB = 50 * MiB, WS_WUKV = 52 * MiB, WS_WO = 53 * MiB, WS_ROPE = 56 * MiB;
constexpr size_t WS_HN = 64 * MiB, WS_Y = 128 * MiB, WS_KWT = 128 * MiB, WS_PROJ = 192 * MiB, WS_VT = 384 * MiB, WS_H1 = 192 * MiB;
constexpr size_t WS_HNKV = 192 * MiB, WS_CKV = 256 * MiB, WS_QA = 288 * MiB, WS_CKVN = 320 * MiB, WS_QAN = 336 * MiB, WS_KR = 360 * MiB, WS_KV = 364 * MiB, WS_Q = 192 * MiB;
constexpr size_t WS_XB = 448 * MiB;
constexpr size_t WS_END = 512 * MiB;
constexpr int LDS_BYTES = 147456;

__device__ __forceinline__ unsigned cvtpk(float lo, float hi) { f32x2 v = {lo, hi}; bf16x2_t b = __builtin_convertvector(v, bf16x2_t); return __builtin_bit_cast(unsigned, b); }
__device__ __forceinline__ float bflo(unsigned u) { return __uint_as_float(u << 16); }
__device__ __forceinline__ float bfhi(unsigned u) { return __uint_as_float(u & 0xffff0000u); }
__device__ __forceinline__ float bf1(unsigned short h) { return __uint_as_float((unsigned)h << 16); }
__device__ __forceinline__ s16x8 pack8(f32x4 a, f32x4 b) { u32x4 w; w.x = cvtpk(a[0], a[1]); w.y = cvtpk(a[2], a[3]); w.z = cvtpk(b[0], b[1]); w.w = cvtpk(b[2], b[3]); return __builtin_bit_cast(s16x8, w); }
__device__ __forceinline__ s16x8 cat4(s16x4 a, s16x4 b) { return __builtin_shufflevector(a, b, 0, 1, 2, 3, 4, 5, 6, 7); }
#define MK_DPP_ADD(v, ctrl) ((v) + __uint_as_float((unsigned)__builtin_amdgcn_update_dpp(0, (int)__float_as_uint(v), (ctrl), 0xF, 0xF, true)))
__device__ __forceinline__ float wave_sum(float v) {
    v = MK_DPP_ADD(v, 0xB1); v = MK_DPP_ADD(v, 0x4E); v = MK_DPP_ADD(v, 0x141); v = MK_DPP_ADD(v, 0x140);
    v += __shfl_xor(v, 16);
    const auto rr = __builtin_amdgcn_permlane32_swap(__float_as_uint(v), __float_as_uint(v), false, false);
    return __uint_as_float(rr[0]) + __uint_as_float(rr[1]);
}
#define MK_DPP_F(v, ctrl) __uint_as_float((unsigned)__builtin_amdgcn_update_dpp(0, (int)__float_as_uint(v), (ctrl), 0xF, 0xF, true))
__device__ __forceinline__ float wave_max(float v) {
    v = fmaxf(v, MK_DPP_F(v, 0xB1)); v = fmaxf(v, MK_DPP_F(v, 0x4E)); v = fmaxf(v, MK_DPP_F(v, 0x141)); v = fmaxf(v, MK_DPP_F(v, 0x140));
    v = fmaxf(v, __shfl_xor(v, 16));
    const auto rr = __builtin_amdgcn_permlane32_swap(__float_as_uint(v), __float_as_uint(v), false, false);
    return fmaxf(__uint_as_float(rr[0]), __uint_as_float(rr[1]));
}
#define MFMA16(a, b, c) __builtin_amdgcn_mfma_f32_16x16x32_bf16((a), (b), (c), 0, 0, 0)
#define MFMA32(a, b, c) __builtin_amdgcn_mfma_f32_32x32x16_bf16((a), (b), (c), 0, 0, 0)

struct Args { const float* in[22]; float* out; unsigned char* ws; };
struct Ctx {
    LAS unsigned char* lds; unsigned char* ws; int tid, lane, wave, G;
};
__device__ __forceinline__ Ctx mkctx(unsigned char* lds_raw, unsigned char* ws) {
    Ctx c; int t = threadIdx.x; asm volatile("" : "+v"(t)); c.tid = t; c.lane = t & 63; c.wave = __builtin_amdgcn_readfirstlane(t >> 6); c.lds = (LAS unsigned char*)lds_raw; c.ws = ws; c.G = gridDim.x; return c; }

__device__ __forceinline__ void p0_transpose_item(const float* W, int ldw, int ncols, int K, bf16_t* WT, LAS float* scr, int item, int lane) {
    const int nblk = ncols / 32, kb = item / nblk, nb = item % nblk, k0 = 64 * kb, n0 = 32 * nb;
#pragma unroll 8
    for (int i = 0; i < 32; ++i) { const int kk = 2 * i + (lane >> 5); scr[kk * 33 + (lane & 31)] = W[(size_t)(k0 + kk) * ldw + n0 + (lane & 31)]; }
    asm volatile("s_waitcnt lgkmcnt(0)" ::: "memory");
    const int c = lane & 7;
#pragma unroll
    for (int j = 0; j < 4; ++j) { const int n = (lane >> 3) + 8 * j; const LAS float* s = scr + (8 * c) * 33 + n;
        u32x4 o; o.x = cvtpk(s[0 * 33], s[1 * 33]); o.y = cvtpk(s[2 * 33], s[3 * 33]); o.z = cvtpk(s[4 * 33], s[5 * 33]); o.w = cvtpk(s[6 * 33], s[7 * 33]);
        *(u32x4*)(WT + (size_t)(n0 + n) * K + k0 + 8 * c) = o; }
    asm volatile("s_waitcnt lgkmcnt(0)" ::: "memory");
}

__device__ __forceinline__ void p0_weights(const Ctx& c, const Args& a, int part, int bidx, int nblk) {
    unsigned char* ws = c.ws;
    LAS float* scr = (LAS float*)(c.lds + c.wave * 8704);
    const int gw = bidx * 8 + c.wave, NGW = nblk * 8;
    constexpr int I_IN = 16 * 96, I_OUT = 16 * 32, I_W1 = 16 * 128, I_W2 = 64 * 32, I_QA = 16 * 12, I_DKV = 16 * 10, I_QB = 6 * 48, I_UKV = 4 * 64, I_O = 16 * 32;
    if (part == 0) {
        for (int it = gw; it < I_IN; it += NGW) p0_transpose_item(a.in[8], APROJ, APN, 1024, (bf16_t*)(ws + WS_WIN), scr, it, c.lane);
    } else {
        constexpr int NITEMS = I_OUT + 2 * I_W1 + 2 * I_W2 + I_QA + I_DKV + I_QB + I_UKV + I_O;
        for (int it = gw; it < NITEMS; it += NGW) {
            int r = it;
            if (r < I_OUT) { p0_transpose_item(a.in[11], 1024, 1024, 1024, (bf16_t*)(ws + WS_WOUT), scr, r, c.lane); continue; } r -= I_OUT;
            if (r < I_W1) { p0_transpose_item(a.in[6], 4096, 4096, 1024, (bf16_t*)(ws + WS_W1A), scr, r, c.lane); continue; } r -= I_W1;
            if (r < I_W2) { p0_transpose_item(a.in[7], 1024, 1024, 4096, (bf16_t*)(ws + WS_W2A), scr, r, c.lane); continue; } r -= I_W2;
            if (r < I_W1) { p0_transpose_item(a.in[6] + (size_t)1024 * 4096, 4096, 4096, 1024, (bf16_t*)(ws + WS_W1B), scr, r, c.lane); continue; } r -= I_W1;
            if (r < I_W2) { p0_transpose_item(a.in[7] + (size_t)4096 * 1024, 1024, 1024, 4096, (bf16_t*)(ws + WS_W2B), scr, r, c.lane); continue; } r -= I_W2;
            if (r < I_QA) { p0_transpose_item(a.in[12], 384, 384, 1024, (bf16_t*)(ws + WS_WQA), scr, r, c.lane); continue; } r -= I_QA;
            if (r < I_DKV) { p0_transpose_item(a.in[19], 320, 320, 1024, (bf16_t*)(ws + WS_WDKV), scr, r, c.lane); continue; } r -= I_DKV;
            if (r < I_QB) { p0_transpose_item(a.in[14], 1536, 1536, 384, (bf16_t*)(ws + WS_WQB), scr, r, c.lane); continue; } r -= I_QB;
            if (r < I_UKV) { p0_transpose_item(a.in[21], 2048, 2048, 256, (bf16_t*)(ws + WS_WUKV), scr, r, c.lane); continue; } r -= I_UKV;
            p0_transpose_item(a.in[15], 1024, 1024, 1024, (bf16_t*)(ws + WS_WO), scr, r, c.lane);
        }
        const int gt = bidx * 512 + c.tid, NT = nblk * 512; const u32x4 z = {0u, 0u, 0u, 0u};
        u32x4* p1 = (u32x4*)(ws + WS_WQA + (size_t)384 * 1024 * 2); for (int i = gt; i < 128 * 1024 * 2 / 16; i += NT) p1[i] = z;
        u32x4* p2 = (u32x4*)(ws + WS_WDKV + (size_t)320 * 1024 * 2); for (int i = gt; i < 192 * 1024 * 2 / 16; i += NT) p2[i] = z;
    }
}

__device__ __forceinline__ void p0_prologue(const Ctx& c, const Args& a) {
    unsigned char* ws = c.ws;
    LAS float* cact = (LAS float*)(c.lds + 69632);
    LAS float* red = (LAS float*)(c.lds + 86016);
    for (int i = c.tid; i < 4096; i += 512) { const float cv = a.in[1][i]; cact[i] = cv / (1.f + expf(-cv)); }
    __syncthreads();
    float* MODS = (float*)(ws + WS_MODS);
    for (int cgp = blockIdx.x; cgp < 224; cgp += c.G) {
        const int gcb = cgp * 64; const float* W; int ld, colb, dstride; const float* bias; float* dst;
        if (gcb < 12288) { const int l = gcb / 6144; colb = gcb - l * 6144; W = a.in[3] + (size_t)l * 1024 * 6144; ld = 6144; bias = a.in[4] + l * 6144; dst = MODS + l * 4 * 6144; dstride = 6144; }
        else { colb = gcb - 12288; W = a.in[16]; ld = 2048; bias = a.in[17]; dst = MODS + 49152; dstride = 2048; }
        float acc0 = 0.f, acc1 = 0.f, acc2 = 0.f, acc3 = 0.f;
        const float* wp = W + (size_t)(128 * c.wave) * ld + colb + c.lane;
#pragma unroll 16
        for (int k = 0; k < 128; ++k) { const float wv = wp[(size_t)k * ld]; const int kk = 128 * c.wave + k;
            acc0 += cact[kk] * wv; acc1 += cact[1024 + kk] * wv; acc2 += cact[2048 + kk] * wv; acc3 += cact[3072 + kk] * wv; }
        red[(c.wave * 4 + 0) * 64 + c.lane] = acc0; red[(c.wave * 4 + 1) * 64 + c.lane] = acc1; red[(c.wave * 4 + 2) * 64 + c.lane] = acc2; red[(c.wave * 4 + 3) * 64 + c.lane] = acc3;
        __syncthreads();
        if (c.tid < 256) { const int b = c.tid >> 6, l = c.tid & 63; float s = 0.f;
#pragma unroll
            for (int w = 0; w < 8; ++w) s += red[(w * 4 + b) * 64 + l];
            dst[b * dstride + colb + l] = s + bias[colb + l]; }
        __syncthreads();
    }
    p0_weights(c, a, 0, blockIdx.x, c.G);
    if (c.G != 256) p0_weights(c, a, 1, blockIdx.x, c.G);
}

template <bool HASY, int XIN  , int XOUT  , int NHN, bool GATES>
__device__ __forceinline__ void normpass(const Ctx& c, const void* xin, const bf16_t* Y, const float* gate, int gstride, const float* gpost, void* xout,
                                         bf16_t* hn0, const float* gain0, const float* sh0, const float* sc0, int st0,
                                         bf16_t* hn1, const float* gain1, const float* sh1, const float* sc1, int st1,
                                         const float* w_in, const float* bg, float* gates_out) {
    LAS float* wg = (LAS float*)c.lds;
    if (GATES) { for (int i = c.tid; i < 8192; i += 512) wg[(i & 7) * 1024 + (i >> 3)] = w_in[(size_t)(i >> 3) * APROJ + APN + (i & 7)]; __syncthreads(); }
    const int gw = blockIdx.x * 8 + c.wave, NGW = c.G * 8, lane = c.lane;
    for (int m0 = gw * 16; m0 < M; m0 += NGW * 16) {
        const int b = m0 >> 13;
        f32x4 Gv[4], A0[4], B0[4], A1[4], B1[4];
#pragma unroll
        for (int j = 0; j < 4; ++j) {
            if (HASY) Gv[j] = ((const f32x4*)gpost)[lane + 64 * j] * ((const f32x4*)(gate + (size_t)b * gstride))[lane + 64 * j];
            if (NHN > 0) { A0[j] = ((const f32x4*)gain0)[lane + 64 * j] * (((const f32x4*)(sc0 + (size_t)b * st0))[lane + 64 * j] + 1.f); B0[j] = ((const f32x4*)(sh0 + (size_t)b * st0))[lane + 64 * j]; }
            if (NHN > 1) { A1[j] = ((const f32x4*)gain1)[lane + 64 * j] * (((const f32x4*)(sc1 + (size_t)b * st1))[lane + 64 * j] + 1.f); B1[j] = ((const f32x4*)(sh1 + (size_t)b * st1))[lane + 64 * j]; }
        }
#pragma unroll 2
        for (int i = 0; i < 16; ++i) {
            const int m = m0 + i;
            f32x4 v[4];
            if (XIN == 0) { const f32x4* xr = (const f32x4*)((const float*)xin + (size_t)m * DM) + lane;
#pragma unroll
                for (int j = 0; j < 4; ++j) v[j] = xr[64 * j]; }
            else { const u32x2* xr = (const u32x2*)((const bf16_t*)xin + (size_t)m * DM) + lane;
#pragma unroll
                for (int j = 0; j < 4; ++j) { const u32x2 u = xr[64 * j]; v[j] = (f32x4){bflo(u.x), bfhi(u.x), bflo(u.y), bfhi(u.y)}; } }
            if (HASY) {
                const u32x2* yr = (const u32x2*)(Y + (size_t)m * DM) + lane; f32x4 y[4]; float ss = 0.f;
#pragma unroll
                for (int j = 0; j < 4; ++j) { const u32x2 u = yr[64 * j]; y[j] = (f32x4){bflo(u.x), bfhi(u.x), bflo(u.y), bfhi(u.y)}; ss += (y[j][0] * y[j][0] + y[j][1] * y[j][1]) + (y[j][2] * y[j][2] + y[j][3] * y[j][3]); }
                ss = wave_sum(ss); const float rs = __builtin_amdgcn_rsqf(ss * (1.f / DM) + EPS);
#pragma unroll
                for (int j = 0; j < 4; ++j) v[j] += Gv[j] * (y[j] * rs);
            }
            if (XOUT == 1) { f32x4* xo = (f32x4*)((float*)xout + (size_t)m * DM) + lane;
#pragma unroll
                for (int j = 0; j < 4; ++j) xo[64 * j] = v[j]; }
            if (XOUT == 2) { u32x2* xo = (u32x2*)((bf16_t*)xout + (size_t)m * DM) + lane;
#pragma unroll
                for (int j = 0; j < 4; ++j) { u32x2 wq; wq.x = cvtpk(v[j][0], v[j][1]); wq.y = cvtpk(v[j][2], v[j][3]); xo[64 * j] = wq; v[j] = (f32x4){bflo(wq.x), bfhi(wq.x), bflo(wq.y), bfhi(wq.y)}; } }
            if (NHN > 0) {
                float ss = 0.f;
#pragma unroll
                for (int j = 0; j < 4; ++j) ss += (v[j][0] * v[j][0] + v[j][1] * v[j][1]) + (v[j][2] * v[j][2] + v[j][3] * v[j][3]);
                ss = wave_sum(ss); const float rs = __builtin_amdgcn_rsqf(ss * (1.f / DM) + EPS);
                float ga[8];
#pragma unroll
                for (int g = 0; g < 8; ++g) ga[g] = 0.f;
                u32x2* h0 = (u32x2*)(hn0 + (size_t)m * DM) + lane;
#pragma unroll
                for (int j = 0; j < 4; ++j) { const f32x4 h = (v[j] * rs) * A0[j] + B0[j]; u32x2 w; w.x = cvtpk(h[0], h[1]); w.y = cvtpk(h[2], h[3]); h0[64 * j] = w;
                    if (GATES) {
#pragma unroll
                        for (int g = 0; g < 8; ++g) { const f32x4 w4 = *(const LAS f32x4*)(wg + g * 1024 + 256 * j + 4 * lane);
                            ga[g] += (h[0] * w4[0] + h[1] * w4[1]) + (h[2] * w4[2] + h[3] * w4[3]); }
                    } }
                if (GATES) {
#pragma unroll
                    for (int g = 0; g < 8; ++g) ga[g] = wave_sum(ga[g]);
                    if (lane == 0) {
#pragma unroll
                        for (int g = 0; g < 8; ++g) gates_out[(size_t)m * 8 + g] = ga[g] + bg[g]; }
                }
                if (NHN > 1) { u32x2* h1 = (u32x2*)(hn1 + (size_t)m * DM) + lane;
#pragma unroll
                    for (int j = 0; j < 4; ++j) { const f32x4 h = (v[j] * rs) * A1[j] + B1[j]; u32x2 w; w.x = cvtpk(h[0], h[1]); w.y = cvtpk(h[2], h[3]); h1[64 * j] = w; } }
            }
        }
    }
}

__device__ __forceinline__ void gate_scan(const Ctx& c) {
    if (blockIdx.x >= 16) return;
    const int bh = blockIdx.x, b = bh >> 2, h = bh & 3, lane = c.lane;
    const float* GATES = (const float*)(c.ws + WS_GATES); float* BCUM = (float*)(c.ws + WS_BCUM); float* CHS = (float*)(c.ws + WS_CHS);
    LAS float* cs = (LAS float*)c.lds;
    for (int j = c.wave; j < 128; j += 8) {
        const int m = b * SEQ + 64 * j + lane;
        const float f = GATES[(size_t)m * 8 + 4 + h], ii = GATES[(size_t)m * 8 + h];
        float v = fminf(f, 0.f) - log1pf(expf(-fabsf(f)));
        v += MK_DPP_F(v, 0x111); v += MK_DPP_F(v, 0x112); v += MK_DPP_F(v, 0x114); v += MK_DPP_F(v, 0x118);
        { const float r0 = __shfl(v, 15), r1 = __shfl(v, 31), r2 = __shfl(v, 47); const int row = lane >> 4;
          v += (row >= 1 ? r0 : 0.f) + (row >= 2 ? r1 : 0.f) + (row >= 3 ? r2 : 0.f); }
        const float blast = __shfl(v, 63);
        const float gm = wave_max(blast - v + ii);
        BCUM[(size_t)m * 4 + h] = v;
        if (lane == 0) { cs[2 * j] = blast; cs[2 * j + 1] = gm; }
    }
    __syncthreads();
    if (c.tid == 0) { float Mx = 0.f;
        for (int j = 0; j < 128; ++j) { const float bl = cs[2 * j], gm = cs[2 * j + 1]; const float Mn = fmaxf(bl + Mx, gm); const int ch = bh * 128 + j;
            CHS[ch] = Mx; CHS[2048 + ch] = Mn; CHS[4096 + ch] = expf(bl + Mx - Mn); Mx = Mn; } }
    __syncthreads();
}

__device__ __forceinline__ float fexp(float x) { return __builtin_amdgcn_exp2f(x * 1.4426950408889634f); }
constexpr int PR_VT = 0, PR_KW = 36864, PR_AS = 55296, PR_BT = 55552, PR_BUF = 55808;
__device__ __forceinline__ void mlstm_pre(const Ctx& c, float* NUM) {
    const int tid = c.tid, lane = c.lane, w = c.wave, g = lane >> 4, cc = lane & 15, Tt = w >> 1, dvh = w & 1;
    const bf16_t* PROJ = (const bf16_t*)(c.ws + WS_PROJ); bf16_t* KWT = (bf16_t*)(c.ws + WS_KWT); bf16_t* VT = (bf16_t*)(c.ws + WS_VT);
    const float* GATES = (const float*)(c.ws + WS_GATES); const float* BCUM = (const float*)(c.ws + WS_BCUM); const float* CHS = (const float*)(c.ws + WS_CHS);
    float* WINT = (float*)(c.ws + WS_WINT); float* ENEG = (float*)(c.ws + WS_ENEG); float* DENI = (float*)(c.ws + WS_DENI);
    const float scale = 0.08838834764831845f;
    int it = 0;
    for (int ch = blockIdx.x; ch < 2048; ch += c.G, ++it) {
        LAS unsigned char* buf = c.lds + (it & 1) * PR_BUF;
        LAS unsigned short* vT = (LAS unsigned short*)(buf + PR_VT); LAS unsigned short* kT = (LAS unsigned short*)(buf + PR_KW);
        LAS float* las = (LAS float*)(buf + PR_AS); LAS float* lbt = (LAS float*)(buf + PR_BT);
        const int bh = ch >> 7, j = ch & 127, b = bh >> 2, h = bh & 3; const int row0 = b * SEQ + 64 * j;
        const float Mprev = CHS[ch], Mnew = CHS[2048 + ch];
        const int ms = row0 + lane;
        const float bt_l = BCUM[(size_t)ms * 4 + h], i_l = GATES[(size_t)ms * 8 + h];
        s16x8 vx[4], kx[2];
        { const bf16_t* vsrc = PROJ + (size_t)ms * APN + 1024 + h * 256 + 32 * w;
#pragma unroll
          for (int i = 0; i < 4; ++i) vx[i] = *(const s16x8*)(vsrc + 8 * i);
          const bf16_t* ksrc = PROJ + (size_t)ms * APN + 512 + h * 128 + 16 * w;
#pragma unroll
          for (int i = 0; i < 2; ++i) kx[i] = *(const s16x8*)(ksrc + 8 * i); }
        __builtin_amdgcn_sched_barrier(0);
        s16x8 kf[4][4], qf[4];
        { const bf16_t* kb = PROJ + (size_t)(row0 + cc) * APN + 512 + h * 128 + 8 * g;
#pragma unroll
          for (int Ts = 0; Ts < 4; ++Ts)
#pragma unroll
              for (int kk = 0; kk < 4; ++kk) kf[Ts][kk] = *(const s16x8*)(kb + (size_t)16 * Ts * APN + 32 * kk);
          const bf16_t* qb = PROJ + (size_t)(row0 + 16 * Tt + cc) * APN + h * 128 + 8 * g;
#pragma unroll
          for (int kk = 0; kk < 4; ++kk) qf[kk] = *(const s16x8*)(qb + 32 * kk); }
        __builtin_amdgcn_sched_barrier(0);
        { const float blast = __shfl(bt_l, 63);
          const float wk_l = fexp(blast - bt_l + i_l - Mnew);
          if (w == 0) { las[lane] = i_l - bt_l; lbt[lane] = bt_l; }
#pragma unroll
          for (int i = 0; i < 4; ++i) {
#pragma unroll
              for (int e = 0; e < 8; ++e) vT[(32 * w + 8 * i + e) * 72 + lane] = (unsigned short)vx[i][e]; }
#pragma unroll
          for (int i = 0; i < 2; ++i) {
#pragma unroll
              for (int e = 0; e < 8; e += 2) { const unsigned pk = cvtpk(bf1((unsigned short)kx[i][e]) * wk_l, bf1((unsigned short)kx[i][e + 1]) * wk_l);
                  kT[(16 * w + 8 * i + e) * 72 + lane] = (unsigned short)(pk & 0xffffu); kT[(16 * w + 8 * i + e + 1) * 72 + lane] = (unsigned short)(pk >> 16); } } }
        __builtin_amdgcn_sched_barrier(0);
        asm volatile("s_waitcnt lgkmcnt(0)" ::: "memory"); __builtin_amdgcn_s_barrier(); asm volatile("" ::: "memory");
        f32x4 st[4];
#pragma unroll
        for (int Ts = 0; Ts < 4; ++Ts) { st[Ts] = (f32x4){0.f, 0.f, 0.f, 0.f};
#pragma unroll
            for (int kk = 0; kk < 4; ++kk) st[Ts] = MFMA16(kf[Ts][kk], qf[kk], st[Ts]); }
        const int t = 16 * Tt + cc; const float btt = lbt[t];
        f32x4 dd[4]; float dmax = -INFINITY;
#pragma unroll
        for (int Ts = 0; Ts < 4; ++Ts) { const f32x4 av = *(const LAS f32x4*)(las + 16 * Ts + 4 * g);
#pragma unroll
            for (int jj = 0; jj < 4; ++jj) { const int s = 16 * Ts + 4 * g + jj; const float d = btt + av[jj]; dd[Ts][jj] = d; if (s <= t) dmax = fmaxf(dmax, d); } }
        dmax = fmaxf(dmax, __shfl_xor(dmax, 16)); dmax = fmaxf(dmax, __shfl_xor(dmax, 32));
        const float mt = fmaxf(btt + Mprev, dmax);
        float psum = 0.f; f32x4 p[4];
#pragma unroll
        for (int Ts = 0; Ts < 4; ++Ts)
#pragma unroll
            for (int jj = 0; jj < 4; ++jj) { const int s = 16 * Ts + 4 * g + jj; const float pv = (s <= t) ? fexp(dd[Ts][jj] - mt) * st[Ts][jj] * scale : 0.f; p[Ts][jj] = pv; psum += pv; }
        psum += __shfl_xor(psum, 16); psum += __shfl_xor(psum, 32);
        const s16x8 pb0 = pack8(p[0], p[1]), pb1 = pack8(p[2], p[3]);
        bf16_t* nrow = (bf16_t*)NUM + (size_t)(row0 + t) * DM + h * 256 + 128 * dvh + 4 * g;
#pragma unroll
        for (int Td = 0; Td < 8; ++Td) {
            const LAS unsigned short* vr = vT + (128 * dvh + 16 * Td + cc) * 72 + 4 * g;
            const s16x8 a0 = cat4(*(const LAS s16x4*)(vr), *(const LAS s16x4*)(vr + 16));
            const s16x8 a1 = cat4(*(const LAS s16x4*)(vr + 32), *(const LAS s16x4*)(vr + 48));
            f32x4 o = (f32x4){0.f, 0.f, 0.f, 0.f};
            o = MFMA16(a0, pb0, o); o = MFMA16(a1, pb1, o);
            { u32x2 ow; ow.x = cvtpk(o[0], o[1]); ow.y = cvtpk(o[2], o[3]); *(u32x2*)(nrow + 16 * Td) = ow; }
        }
        if (dvh == 0 && g == 0) { const size_t ix = (size_t)(row0 + t) * 4 + h; WINT[ix] = expf(btt + Mprev - mt) * scale; ENEG[ix] = expf(-mt); DENI[ix] = psum; }
#pragma unroll
        for (int i = 0; i < 4; ++i) { const int pi = tid + 512 * i; *(s16x8*)(VT + (size_t)ch * (272 * 64) + (size_t)pi * 8) = *(const LAS s16x8*)(buf + PR_VT + (pi >> 3) * 144 + (pi & 7) * 16); }
#pragma unroll
        for (int i = 0; i < 2; ++i) { const int pi = tid + 512 * i; *(s16x8*)(KWT + (size_t)ch * 8192 + (size_t)pi * 8) = *(const LAS s16x8*)(buf + PR_KW + (pi >> 3) * 144 + (pi & 7) * 16); }
        if (tid < 128) { const short ov = (tid < 8) ? (short)0x3F80 : (short)0; const s16x8 o8 = {ov, ov, ov, ov, ov, ov, ov, ov}; *(s16x8*)(VT + (size_t)ch * (272 * 64) + (size_t)(2048 + tid) * 8) = o8; }
    }
}

constexpr int SQ_KWO = 0, SQ_QO = 16384, SQ_VTO = 32768, SQ_WO = 36864, SQ_STG = 37888, SQ_DEC = 3 * SQ_STG;
__device__ __forceinline__ void mlstm_seq(const Ctx& c, const Args& a) {
    int bh, sp;
    if (c.G == 256) { const int x = blockIdx.x & 7, li = blockIdx.x >> 3; if (li >= 18) { p0_weights(c, a, 1, (li - 18) * 8 + x, 112); return; } bh = 2 * x + li / 9; sp = li % 9; }
    else { if ((int)blockIdx.x >= 144) return; bh = blockIdx.x / 9; sp = blockIdx.x % 9; }
    const int tid = c.tid, lane = c.lane, w = c.wave, g = lane >> 4, cc = lane & 15, si = w >> 2, Tt = w & 3, sl = 2 * sp + si, b = bh >> 2, h = bh & 3;
    const bool active = sl < 17;
    const bf16_t* PROJ = (const bf16_t*)(c.ws + WS_PROJ); const bf16_t* KWT = (const bf16_t*)(c.ws + WS_KWT); const bf16_t* VT = (const bf16_t*)(c.ws + WS_VT);
    const float* CHS = (const float*)(c.ws + WS_CHS); const float* WINT = (const float*)(c.ws + WS_WINT); float* DEN = (float*)(c.ws + WS_DEN); bf16_t* INTER = (bf16_t*)(c.ws + WS_HN);
    unsigned kwoff[2], qoff[2], xoff; const bool isv = w < 4;
#pragma unroll
    for (int i = 0; i < 2; ++i) { const int I = 2 * w + i; const int row = 8 * I + (lane >> 3); kwoff[i] = (unsigned)(row * 64 + 8 * ((lane & 7) ^ (row & 7)));
        const int t = 4 * I + (lane >> 4); qoff[i] = (unsigned)(t * APN + h * 128 + 8 * ((lane & 15) ^ (t & 15))); }
    { const int rr = 8 * (w & 3) + (lane >> 3); int slc = 2 * sp + (rr >> 4); if (slc > 16) slc = 16;
      xoff = isv ? (unsigned)((16 * slc + (rr & 15)) * 64 + 8 * ((lane & 7) ^ (rr & 7))) : (unsigned)(lane * 4); }
#define SQ_DMA(k) do { const unsigned ch_ = (unsigned)(bh * 128 + (k)); const size_t row0_ = (size_t)(b * SEQ + 64 * (k)); LAS unsigned char* sb_ = c.lds + ((k) % 3) * SQ_STG; \
        __builtin_amdgcn_global_load_lds((const unsigned*)(KWT + (size_t)ch_ * 8192 + kwoff[0]), (LAS unsigned*)(sb_ + SQ_KWO + (2 * w) * 1024), 16, 0, 0); \
        __builtin_amdgcn_global_load_lds((const unsigned*)(KWT + (size_t)ch_ * 8192 + kwoff[1]), (LAS unsigned*)(sb_ + SQ_KWO + (2 * w + 1) * 1024), 16, 0, 0); \
        __builtin_amdgcn_global_load_lds((const unsigned*)(PROJ + row0_ * APN + qoff[0]), (LAS unsigned*)(sb_ + SQ_QO + (2 * w) * 1024), 16, 0, 0); \
        __builtin_amdgcn_global_load_lds((const unsigned*)(PROJ + row0_ * APN + qoff[1]), (LAS unsigned*)(sb_ + SQ_QO + (2 * w + 1) * 1024), 16, 0, 0); \
        const void* xs_ = isv ? (const void*)(VT + (size_t)ch_ * (272 * 64) + xoff) : (const void*)(WINT + row0_ * 4 + xoff); \
        __builtin_amdgcn_global_load_lds((const unsigned*)xs_, (LAS unsigned*)(sb_ + (isv ? SQ_VTO + (w & 3) * 1024 : SQ_WO)), 16, 0, 0); } while (0)
    SQ_DMA(0); SQ_DMA(1);
    LAS float* dectab = (LAS float*)(c.lds + SQ_DEC);
    if (tid < 128) dectab[tid] = CHS[4096 + bh * 128 + tid];
    constexpr int SQ_EX = SQ_DEC + 512;
    { LAS u32x4* ex = (LAS u32x4*)(c.lds + SQ_EX); for (int i = tid; i < 1024; i += 512) ex[i] = (u32x4){0u, 0u, 0u, 0u}; }
    f32x4 C0 = (f32x4){0.f, 0.f, 0.f, 0.f}, C1 = (f32x4){0.f, 0.f, 0.f, 0.f};
    s16x8 aown = (s16x8){0, 0, 0, 0, 0, 0, 0, 0};
    const int qsw = cc, ksw = cc & 7;
#pragma unroll 1
    for (int j = 0; j < 128; ++j) {
        if (j == 127) asm volatile("s_waitcnt vmcnt(0)" ::: "memory"); else if (active && j >= 2) asm volatile("s_waitcnt vmcnt(7)" ::: "memory"); else asm volatile("s_waitcnt vmcnt(5)" ::: "memory");
        asm volatile("s_waitcnt lgkmcnt(0)" ::: "memory"); __builtin_amdgcn_s_barrier(); asm volatile("" ::: "memory");
        if (j + 2 < 128) SQ_DMA(j + 2);
        if (active) {
            const LAS unsigned char* sb_ = c.lds + (j % 3) * SQ_STG; const int row_ = b * SEQ + 64 * j + 16 * Tt + cc;
            const LAS unsigned char* exr_ = c.lds + SQ_EX + (((j + 1) & 1) * 2 + si) * 4096 + lane * 16;
            f32x4 acc_ = (f32x4){0.f, 0.f, 0.f, 0.f}; const LAS unsigned char* qa_ = sb_ + SQ_QO + (16 * Tt + cc) * 256 + 8 * (g & 1);
#pragma unroll
            for (int ks = 0; ks < 4; ++ks) { const s16x8 a_ = (ks == Tt) ? aown : *(const LAS s16x8*)(exr_ + ks * 1024);
                const s16x8 b_ = cat4(*(const LAS s16x4*)(qa_ + (((4 * ks + (g >> 1)) ^ qsw) << 4)), *(const LAS s16x4*)(qa_ + (((4 * ks + 2 + (g >> 1)) ^ qsw) << 4))); acc_ = MFMA16(a_, b_, acc_); }
            const float wv_ = *(const LAS float*)(sb_ + SQ_WO + 16 * (16 * Tt + cc) + 4 * h);
            if (sl < 16) { u32x2 o_; o_.x = cvtpk(acc_[0] * wv_, acc_[1] * wv_); o_.y = cvtpk(acc_[2] * wv_, acc_[3] * wv_); *(u32x2*)(INTER + (size_t)row_ * DM + h * 256 + 16 * sl + 4 * g) = o_; }
            else if (g == 0) DEN[(size_t)row_ * 4 + h] = wv_ * acc_[0];
            const float dec_ = dectab[j]; const LAS unsigned char* ka_ = sb_ + SQ_KWO + (32 * Tt + cc) * 128; const LAS unsigned char* va_ = sb_ + SQ_VTO + (si * 16 + cc) * 128;
            const s16x8 v0_ = *(const LAS s16x8*)(va_ + ((g ^ ksw) << 4)), v1_ = *(const LAS s16x8*)(va_ + (((4 + g) ^ ksw) << 4));
            C0 = C0 * dec_; C0 = MFMA16(*(const LAS s16x8*)(ka_ + ((g ^ ksw) << 4)), v0_, C0); C0 = MFMA16(*(const LAS s16x8*)(ka_ + (((4 + g) ^ ksw) << 4)), v1_, C0);
            C1 = C1 * dec_; C1 = MFMA16(*(const LAS s16x8*)(ka_ + 16 * 128 + ((g ^ ksw) << 4)), v0_, C1); C1 = MFMA16(*(const LAS s16x8*)(ka_ + 16 * 128 + (((4 + g) ^ ksw) << 4)), v1_, C1);
            aown = pack8(C0, C1);
            *(LAS s16x8*)(c.lds + SQ_EX + ((j & 1) * 2 + si) * 4096 + Tt * 1024 + lane * 16) = aown;
        }
    }
#undef SQ_DMA
}

__device__ __forceinline__ void mlstm_post(const Ctx& c, const float* NUM, const float* head_norm, bf16_t* OUT) {
    const int gw = blockIdx.x * 8 + c.wave, NGW = c.G * 8, lane = c.lane;
    const bf16_t* PROJ = (const bf16_t*)(c.ws + WS_PROJ); const float* DEN = (const float*)(c.ws + WS_DEN); const float* ENEG = (const float*)(c.ws + WS_ENEG); const float* DENI = (const float*)(c.ws + WS_DENI);
    for (int m = gw; m < M; m += NGW) {
#pragma unroll
        for (int h = 0; h < 4; ++h) {
            const u32x2 iu = *(const u32x2*)(OUT + (size_t)m * DM + h * 256 + 4 * lane);
            const u32x2 nu = *(const u32x2*)((const bf16_t*)NUM + (size_t)m * DM + h * 256 + 4 * lane);
            const f32x4 nv = (f32x4){bflo(nu.x), bfhi(nu.x), bflo(nu.y), bfhi(nu.y)} + (f32x4){bflo(iu.x), bfhi(iu.x), bflo(iu.y), bfhi(iu.y)};
            const float den = DEN[(size_t)m * 4 + h] + DENI[(size_t)m * 4 + h], en = ENEG[(size_t)m * 4 + h];
            const float inv = __builtin_amdgcn_rcpf(fmaxf(fabsf(den), en));
            const f32x4 hv = nv * inv;
            float ss = (hv[0] * hv[0] + hv[1] * hv[1]) + (hv[2] * hv[2] + hv[3] * hv[3]); ss = wave_sum(ss);
            const float rs = __builtin_amdgcn_rsqf(ss * (1.f / 256.f) + EPS);
            const u32x2 ou = *(const u32x2*)(PROJ + (size_t)m * APN + 2048 + h * 256 + 4 * lane);
            const f32x4 op = {bflo(ou.x), bfhi(ou.x), bflo(ou.y), bfhi(ou.y)};
            const f32x4 hn = *(const f32x4*)(head_norm + h * 256 + 4 * lane);
            f32x4 r;
#pragma unroll
            for (int e = 0; e < 4; ++e) r[e] = (hv[e] * rs * hn[e]) * __builtin_amdgcn_rcpf(1.f + __builtin_amdgcn_exp2f(-1.4426950408889634f * op[e]));
            u32x2 wv; wv.x = cvtpk(r[0], r[1]); wv.y = cvtpk(r[2], r[3]);
            *(u32x2*)(OUT + (size_t)m * DM + h * 256 + 4 * lane) = wv;
        }
    }
}

__device__ __forceinline__ void rope_cs(int pos, int jf, float& cs, float& sn) {
    const float inv = exp2f(-(float)jf * (13.287712379549449f / 32.f));
    const float ang = (float)pos * inv;
    double tt = (double)ang * 0.15915494309189535; tt -= floor(tt);
    const float tf = (float)tt;
    sn = __builtin_amdgcn_sinf(tf); cs = __builtin_amdgcn_cosf(tf);
}

__device__ __forceinline__ void mla_prep(const Ctx& c, const Args& a) {
    const int gw = blockIdx.x * 8 + c.wave, NGW = c.G * 8, lane = c.lane;
    const bf16_t* CKV = (const bf16_t*)(c.ws + WS_CKV); const bf16_t* QA = (const bf16_t*)(c.ws + WS_QA);
    bf16_t* CKVN = (bf16_t*)(c.ws + WS_CKVN); bf16_t* QAN = (bf16_t*)(c.ws + WS_QAN); bf16_t* KR = (bf16_t*)(c.ws + WS_KR); float* ROPE = (float*)(c.ws + WS_ROPE);
    const int* positions = (const int*)a.in[2]; const float* kvl = a.in[20]; const float* qn = a.in[13];
    for (int m = gw; m < M; m += NGW) {
        { const u32x2 u = *(const u32x2*)(CKV + (size_t)m * 512 + 4 * lane); const f32x4 v = {bflo(u.x), bfhi(u.x), bflo(u.y), bfhi(u.y)};
          float ss = (v[0] * v[0] + v[1] * v[1]) + (v[2] * v[2] + v[3] * v[3]); ss = wave_sum(ss); const float rs = __builtin_amdgcn_rsqf(ss * (1.f / 256.f) + EPS);
          const f32x4 gn = *(const f32x4*)(kvl + 4 * lane); u32x2 w; w.x = cvtpk(v[0] * rs * gn[0], v[1] * rs * gn[1]); w.y = cvtpk(v[2] * rs * gn[2], v[3] * rs * gn[3]);
          *(u32x2*)(CKVN + (size_t)m * 256 + 4 * lane) = w; }
        if (lane < 32) { const float x1 = bf1(CKV[(size_t)m * 512 + 256 + lane]), x2 = bf1(CKV[(size_t)m * 512 + 288 + lane]); float cs, sn; rope_cs(positions[m], lane, cs, sn);
          ROPE[(size_t)m * 64 + lane] = cs; ROPE[(size_t)m * 64 + 32 + lane] = sn;
          const unsigned pk = cvtpk(x1 * cs - x2 * sn, x1 * sn + x2 * cs); KR[(size_t)m * 64 + lane] = (bf16_t)(pk & 0xffffu); KR[(size_t)m * 64 + 32 + lane] = (bf16_t)(pk >> 16); }
        { const unsigned* qp = (const unsigned*)(QA + (size_t)m * 512 + 6 * lane); const unsigned u0 = qp[0], u1 = qp[1], u2 = qp[2];
          float v[6] = {bflo(u0), bfhi(u0), bflo(u1), bfhi(u1), bflo(u2), bfhi(u2)};
          float ss = 0.f;
#pragma unroll
          for (int e = 0; e < 6; ++e) ss += v[e] * v[e];
          ss = wave_sum(ss); const float rs = __builtin_amdgcn_rsqf(ss * (1.f / 384.f) + EPS);
          const float* gq = qn + 6 * lane; unsigned* op = (unsigned*)(QAN + (size_t)m * 384 + 6 * lane);
          op[0] = cvtpk(v[0] * rs * gq[0], v[1] * rs * gq[1]); op[1] = cvtpk(v[2] * rs * gq[2], v[3] * rs * gq[3]); op[2] = cvtpk(v[4] * rs * gq[4], v[5] * rs * gq[5]); }
    }
}

constexpr int AK_STRIDE = 200, AV_STRIDE = 72, AK_BYTES = 64 * AK_STRIDE * 2, AV_BYTES = 128 * AV_STRIDE * 2, ABUF = AK_BYTES + AV_BYTES;
__device__ __forceinline__ void attn_unit(const Ctx& c, const Args& a, int b, int h, int u) {
    const bf16_t* KV = (const bf16_t*)a.out;
    const int tid = c.tid, lane = c.lane, w = c.wave, r = lane & 31, hi = lane >> 5;
    const bf16_t* Q = (const bf16_t*)(c.ws + WS_Q); const bf16_t* KR = (const bf16_t*)(c.ws + WS_KR); bf16_t* O = (bf16_t*)(c.ws + WS_HN);
    const int rowb = b * SEQ; const int qrow = rowb + 256 * u + 32 * w + r;
    const int nt = 4 * u + 4, lim = 4 * u + (w >> 1);
    const unsigned knoff = (unsigned)((rowb + (tid >> 4)) * 2048 + h * 256 + 8 * (tid & 15));
    const unsigned kroff = (unsigned)((rowb + (tid >> 3)) * 64 + 8 * (tid & 7));
    const unsigned voff = (unsigned)((rowb + 2 * (tid & 31)) * 2048 + h * 256 + 128 + 8 * (tid >> 5));
    const int vkpos = ((2 * (tid & 31)) & ~12) | (((2 * (tid & 31)) & 4) << 1) | (((2 * (tid & 31)) & 8) >> 1);
    s16x8 sk[3], sv[2];
#define ATT_LOAD(kt) do { sk[0] = *(const s16x8*)(KV + knoff + (unsigned)(kt) * (64u * 2048u)); sk[1] = *(const s16x8*)(KV + knoff + 32u * 2048u + (unsigned)(kt) * (64u * 2048u)); \
        sk[2] = *(const s16x8*)(KR + kroff + (unsigned)(kt) * (64u * 64u)); } while (0)
#define ATT_LOADV(kt) do { _Pragma("unroll") for (int i_ = 0; i_ < 2; ++i_) sv[i_] = *(const s16x8*)(KV + voff + 2048 * i_ + (unsigned)(kt) * (64u * 2048u)); } while (0)
#define ATT_STORE(bufo) do { *(LAS s16x8*)(c.lds + (bufo) + ((tid >> 4) * AK_STRIDE + 8 * (tid & 15)) * 2) = sk[0]; *(LAS s16x8*)(c.lds + (bufo) + (((tid >> 4) + 32) * AK_STRIDE + 8 * (tid & 15)) * 2) = sk[1]; \
        *(LAS s16x8*)(c.lds + (bufo) + ((tid >> 3) * AK_STRIDE + 128 + 8 * (tid & 7)) * 2) = sk[2]; \
        _Pragma("unroll") for (int e_ = 0; e_ < 8; ++e_) *(LAS unsigned*)(c.lds + (bufo) + AK_BYTES + ((8 * (tid >> 5) + e_) * AV_STRIDE + vkpos) * 2) = (unsigned)(unsigned short)sv[0][e_] | ((unsigned)(unsigned short)sv[1][e_] << 16); } while (0)
    ATT_LOAD(0); ATT_LOADV(0);
    s16x8 qf[12];
    { const bf16_t* qp = Q + (size_t)qrow * 1536 + h * 192 + 8 * hi;
#pragma unroll
      for (int kk = 0; kk < 12; ++kk) qf[kk] = *(const s16x8*)(qp + 16 * kk);
      const float* rp = (const float*)(c.ws + WS_ROPE) + (size_t)qrow * 64 + 8 * hi;
#pragma unroll
      for (int kk = 8; kk < 10; ++kk) {
          const f32x4 ca = *(const f32x4*)(rp + 16 * (kk - 8)), cb = *(const f32x4*)(rp + 16 * (kk - 8) + 4), sa = *(const f32x4*)(rp + 32 + 16 * (kk - 8)), sb = *(const f32x4*)(rp + 32 + 16 * (kk - 8) + 4);
          const float cs8[8] = {ca[0], ca[1], ca[2], ca[3], cb[0], cb[1], cb[2], cb[3]}, sn8[8] = {sa[0], sa[1], sa[2], sa[3], sb[0], sb[1], sb[2], sb[3]};
          u32x4 o1, o2;
#pragma unroll
          for (int e = 0; e < 8; e += 2) {
              const float x1a = bf1((unsigned short)qf[kk][e]), x1b = bf1((unsigned short)qf[kk][e + 1]), x2a = bf1((unsigned short)qf[kk + 2][e]), x2b = bf1((unsigned short)qf[kk + 2][e + 1]);
              o1[e >> 1] = cvtpk(x1a * cs8[e] - x2a * sn8[e], x1b * cs8[e + 1] - x2b * sn8[e + 1]); o2[e >> 1] = cvtpk(x1a * sn8[e] + x2a * cs8[e], x1b * sn8[e + 1] + x2b * cs8[e + 1]); }
          qf[kk] = __builtin_bit_cast(s16x8, o1); qf[kk + 2] = __builtin_bit_cast(s16x8, o2);
      } }
    ATT_STORE(0);
    __syncthreads();
    f32x16 o[4];
#pragma unroll
    for (int Td = 0; Td < 4; ++Td)
#pragma unroll
        for (int e = 0; e < 16; ++e) o[Td][e] = 0.f;
    float mrun = -INFINITY, lrun = 0.f;
    const float CS = 0.07216878364870322f * 1.4426950408889634f;
#pragma unroll 1
    for (int kt = 0; kt < nt; ++kt) {
        const int bufo = (kt & 1) * ABUF, nbufo = ((kt + 1) & 1) * ABUF;
        if (kt + 1 < nt) { ATT_LOAD(kt + 1); if (kt > lim) ATT_LOADV(kt + 1); }
        if (kt <= lim) {
            f32x16 s0, s1;
#pragma unroll
            for (int e = 0; e < 16; ++e) { s0[e] = 0.f; s1[e] = 0.f; }
            const LAS unsigned char* kb = c.lds + bufo + (r * AK_STRIDE + 8 * hi) * 2;
            __builtin_amdgcn_s_setprio(1);
#pragma unroll
            for (int kk = 0; kk < 12; ++kk) { const s16x8 k0 = *(const LAS s16x8*)(kb + 32 * kk), k1 = *(const LAS s16x8*)(kb + 32 * AK_STRIDE * 2 + 32 * kk);
                s0 = MFMA32(k0, qf[kk], s0); s1 = MFMA32(k1, qf[kk], s1); }
            __builtin_amdgcn_s_setprio(0);
            float mx = s0[0];
#pragma unroll
            for (int e = 0; e < 16; ++e) { mx = fmaxf(mx, s0[e]); mx = fmaxf(mx, s1[e]); }
            mx = fmaxf(mx, __shfl_xor(mx, 32));
            const float mxs = mx * CS;
            if (__any(mxs - mrun > 8.f)) {
                const float mnew = fmaxf(mrun, mxs);
                const float alpha = __builtin_amdgcn_exp2f(mrun - mnew);
                mrun = mnew; lrun *= alpha;
#pragma unroll
                for (int Td = 0; Td < 4; ++Td)
#pragma unroll
                    for (int e = 0; e < 16; ++e) o[Td][e] *= alpha;
            }
            float ps = 0.f;
#pragma unroll
            for (int e = 0; e < 16; ++e) { s0[e] = __builtin_amdgcn_exp2f(s0[e] * CS - mrun); s1[e] = __builtin_amdgcn_exp2f(s1[e] * CS - mrun); ps += s0[e] + s1[e]; }
            lrun += ps;
            s16x8 pb[4];
            { u32x4 t0, t1, t2, t3;
#pragma unroll
              for (int e = 0; e < 4; ++e) { t0[e] = cvtpk(s0[2 * e], s0[2 * e + 1]); t1[e] = cvtpk(s0[8 + 2 * e], s0[8 + 2 * e + 1]); t2[e] = cvtpk(s1[2 * e], s1[2 * e + 1]); t3[e] = cvtpk(s1[8 + 2 * e], s1[8 + 2 * e + 1]); }
              pb[0] = __builtin_bit_cast(s16x8, t0); pb[1] = __builtin_bit_cast(s16x8, t1); pb[2] = __builtin_bit_cast(s16x8, t2); pb[3] = __builtin_bit_cast(s16x8, t3); }
            if (kt + 1 < nt) ATT_LOADV(kt + 1);
            const LAS unsigned char* vb = c.lds + bufo + AK_BYTES + (r * AV_STRIDE + 8 * hi) * 2;
            __builtin_amdgcn_s_setprio(1);
#pragma unroll
            for (int Td = 0; Td < 4; ++Td)
#pragma unroll
                for (int q2 = 0; q2 < 4; ++q2) {
                    const LAS unsigned char* vp = vb + (32 * Td * AV_STRIDE + 16 * q2) * 2;
                    const s16x8 av = *(const LAS s16x8*)(vp);
                    o[Td] = MFMA32(av, pb[q2], o[Td]); }
        }
        __builtin_amdgcn_s_setprio(0);
        if (kt + 1 < nt) ATT_STORE(nbufo);
        __syncthreads();
    }
    const float ltot = lrun + __shfl_xor(lrun, 32);
    const float inv = 1.f / ltot;
    bf16_t* op = O + (size_t)qrow * DM + h * 128 + 8 * hi;
#pragma unroll
    for (int Td = 0; Td < 4; ++Td)
#pragma unroll
        for (int p = 0; p < 2; ++p) {
            const unsigned x0 = cvtpk(o[Td][8 * p] * inv, o[Td][8 * p + 1] * inv), x1 = cvtpk(o[Td][8 * p + 2] * inv, o[Td][8 * p + 3] * inv);
            const unsigned y0 = cvtpk(o[Td][8 * p + 4] * inv, o[Td][8 * p + 5] * inv), y1 = cvtpk(o[Td][8 * p + 6] * inv, o[Td][8 * p + 7] * inv);
            const auto s0 = __builtin_amdgcn_permlane32_swap(x0, y0, false, false), s1 = __builtin_amdgcn_permlane32_swap(x1, y1, false, false);
            u32x4 wv; wv.x = s0[0]; wv.y = s1[0]; wv.z = s0[1]; wv.w = s1[1];
            *(u32x4*)(op + 32 * Td + 16 * p) = wv; }
#undef ATT_LOAD
#undef ATT_LOADV
#undef ATT_STORE
}
__device__ __forceinline__ void attn_phase(const Ctx& c, const Args& a) {
    const int bx = blockIdx.x; const int vcu = (c.G % 8 == 0) ? (bx % 8) * (c.G / 8) + bx / 8 : bx;
    for (int p = vcu; p < 512; p += c.G) {
        const int bh = p >> 4, u = p & 15, b = bh >> 3, h = bh & 7;
        attn_unit(c, a, b, h, 31 - u);
        attn_unit(c, a, b, h, u);
    }
}

#define XB_TMO      128
#define XB_XCNT(j)  (256  + 64 * (j))
#define XB_XSUB(j)  (1280 + 64 * (j))
#define XB_XGEN(j)  (2304 + 64 * (j))
#define XB_TOP      3328
#define XB_TOPGEN   3392
#define XCD_BAR_WORDS 3456
#define XB_SPIN_CAP (1u << 18)

__device__ __forceinline__ unsigned xb_ld(unsigned* p)              { return __hip_atomic_load(p, __ATOMIC_RELAXED, __HIP_MEMORY_SCOPE_AGENT); }
__device__ __forceinline__ unsigned xb_add(unsigned* p, unsigned v) { return __hip_atomic_fetch_add(p, v, __ATOMIC_RELAXED, __HIP_MEMORY_SCOPE_AGENT); }
__device__ __forceinline__ unsigned xb_xcc_id() { return (unsigned)__builtin_amdgcn_s_getreg((3 << 11) | 20) & 0xFu; }
#define XB_SPIN(cond, bar) do { unsigned _sp = 0; while (cond) { __builtin_amdgcn_s_sleep(1); \
    if ((++_sp & 255u) == 0u) { if (xb_ld(&(bar)[XB_TMO])) break; if (_sp > XB_SPIN_CAP) { atomicAdd(&(bar)[XB_TMO], 1u); break; } } } } while (0)

struct XcdBarrier {
    unsigned* bar; unsigned x;
    volatile LAS unsigned* st;
};

__device__ __forceinline__ XcdBarrier xcd_barrier_post(unsigned* bar, volatile LAS unsigned* st) {
    XcdBarrier b; b.bar = bar; b.x = xb_xcc_id(); b.st = st;
    if (threadIdx.x == 0) (void)xb_add(&bar[XB_XCNT(b.x)], 1u);
    return b;
}
__device__ __forceinline__ void xcd_barrier_complete(unsigned* bar, unsigned x, unsigned& nloc, unsigned& nx) {
    const unsigned G = gridDim.x * gridDim.y * gridDim.z;
    unsigned sum, cnt, mine, sp = 0u;
    for (;;) {
        sum = 0u; cnt = 0u; mine = 0u;
#pragma unroll
        for (unsigned j = 0; j < 16; ++j) { const unsigned c = xb_ld(&bar[XB_XCNT(j)]); sum += c; cnt += (c > 0u) ? 1u : 0u; mine = (j == x) ? c : mine; }
        if (sum == G) break;
        __builtin_amdgcn_s_sleep(1);
        if ((++sp & 255u) == 0u) { if (xb_ld(&bar[XB_TMO])) break; if (sp > XB_SPIN_CAP) { atomicAdd(&bar[XB_TMO], 1u); break; } }
    }
    nloc = mine > 0u ? mine : 1u; nx = cnt > 0u ? cnt : 1u;
}

__device__ __forceinline__ void xcd_barrier(const XcdBarrier& b) {
    asm volatile("s_waitcnt vmcnt(0)" ::: "memory");
    __syncthreads();
    if (threadIdx.x == 0) {
        unsigned* bar = b.bar;
        __builtin_amdgcn_s_waitcnt(0);
        unsigned nloc = b.st[0], nx = b.st[1];
        if (nloc == 0u) { xcd_barrier_complete(bar, b.x, nloc, nx); b.st[0] = nloc; b.st[1] = nx; }
        const unsigned old = xb_add(&bar[XB_XSUB(b.x)], 1u);
        const unsigned gen = old / nloc;
        if (old + 1u == (gen + 1u) * nloc) {
            __builtin_amdgcn_fence(__ATOMIC_RELEASE, "agent");
            asm volatile("s_waitcnt vmcnt(0)" ::: "memory");
            const unsigned og = xb_add(&bar[XB_TOP], 1u);
            const unsigned tg = og / nx;
            if (og + 1u == (tg + 1u) * nx) xb_add(&bar[XB_TOPGEN], 1u);
            else XB_SPIN(xb_ld(&bar[XB_TOPGEN]) == tg, bar);
            __builtin_amdgcn_fence(__ATOMIC_ACQUIRE, "agent");
            xb_add(&bar[XB_XGEN(b.x)], 1u);
            asm volatile("s_waitcnt vmcnt(0)" ::: "memory");
        } else {
            XB_SPIN(xb_ld(&bar[XB_XGEN(b.x)]) == gen, bar);
            __builtin_amdgcn_fence(__ATOMIC_ACQUIRE, "agent");
            asm volatile("s_waitcnt vmcnt(0)" ::: "memory");
        }
    }
    __syncthreads();
}

template <int ACT>
__device__ __forceinline__ void run_gemm(const Ctx& c, const bf16_t* A, const bf16_t* Bt, int N, int K, bf16_t* Out) {
    pg8::Gemm g{A, Bt, M, N, K}; pg8::StaticOrder S; S.init(M, N, c.G, (int)blockIdx.x);
    pg8::EpiBf16<ACT> E{Out, N, nullptr, 0, 0, 1.f};
    pg8::gemm_phase<pg8::EpiBf16<ACT>, pg8::StaticOrder, true, true>(c.lds, g, S, E);
}

__global__ void __launch_bounds__(512, 2) yoco_fwd(Args a) {
    extern __shared__ __attribute__((aligned(16))) unsigned char lds_raw[];
    cg::grid_group grid = cg::this_grid();
#define c mkctx(lds_raw, a.ws)
    unsigned char* ws = a.ws;
    const float* MODS = (const float*)(ws + WS_MODS);
    const float* M0 = MODS; const float* M1 = MODS + 4 * 6144; const float* MKV = MODS + 49152;
    const float* ng = a.in[5];
    bf16_t* HN = (bf16_t*)(ws + WS_HN); bf16_t* Yb = (bf16_t*)(ws + WS_Y); bf16_t* H1 = (bf16_t*)(ws + WS_H1); bf16_t* PROJ = (bf16_t*)(ws + WS_PROJ);
    float* X = a.out; bf16_t* XB = (bf16_t*)(ws + WS_XB);
    if (threadIdx.x < 64) ((LAS unsigned*)((LAS unsigned char*)lds_raw + 131072))[threadIdx.x] = 0u;
    __syncthreads();
    XcdBarrier xbar = xcd_barrier_post((unsigned*)ws, (volatile LAS unsigned*)((LAS unsigned char*)lds_raw + 131072));
#define GSYNC() xcd_barrier(xbar)
    grid.sync();
    p0_prologue(c, a); GSYNC();
    normpass<false, 0, 0, 1, true>(c, a.in[0], nullptr, nullptr, 0, nullptr, nullptr, HN, ng + 0, M0 + 0, M0 + 1024, 6144, nullptr, nullptr, nullptr, nullptr, 0,
                                    a.in[8], a.in[9], (float*)(ws + WS_GATES));
    GSYNC();
    gate_scan(c);
    run_gemm<0>(c, HN, (const bf16_t*)(ws + WS_WIN), APN, 1024, PROJ);
    GSYNC();
    mlstm_pre(c, X); GSYNC();
    mlstm_seq(c, a); GSYNC();
    mlstm_post(c, X, a.in[10], HN); GSYNC();
    run_gemm<0>(c, HN, (const bf16_t*)(ws + WS_WOUT), 1024, 1024, Yb); GSYNC();
    normpass<true, 0, 2, 1, false>(c, a.in[0], Yb, M0 + 2048, 6144, ng + 1024, XB, HN, ng + 2048, M0 + 3072, M0 + 4096, 6144, nullptr, nullptr, nullptr, nullptr, 0, nullptr, nullptr, nullptr);
    GSYNC();
    run_gemm<2>(c, HN, (const bf16_t*)(ws + WS_W1A), DFF, 1024, H1); GSYNC();
    run_gemm<0>(c, H1, (const bf16_t*)(ws + WS_W2A), 1024, DFF, Yb); GSYNC();
    normpass<true, 1, 2, 2, false>(c, XB, Yb, M0 + 5120, 6144, ng + 3072, XB, HN, ng + 4096, M1 + 0, M1 + 1024, 6144, (bf16_t*)(ws + WS_HNKV), a.in[18], MKV + 0, MKV + 1024, 2048,
                                   nullptr, nullptr, nullptr);
    GSYNC();
    run_gemm<0>(c, (const bf16_t*)(ws + WS_HNKV), (const bf16_t*)(ws + WS_WDKV), 512, 1024, (bf16_t*)(ws + WS_CKV));
    run_gemm<0>(c, HN, (const bf16_t*)(ws + WS_WQA), 512, 1024, (bf16_t*)(ws + WS_QA));
    GSYNC();
    mla_prep(c, a); GSYNC();
    run_gemm<0>(c, (const bf16_t*)(ws + WS_CKVN), (const bf16_t*)(ws + WS_WUKV), 2048, 256, (bf16_t*)a.out);
    run_gemm<0>(c, (const bf16_t*)(ws + WS_QAN), (const bf16_t*)(ws + WS_WQB), 1536, 384, (bf16_t*)(ws + WS_Q));
    GSYNC();
    attn_phase(c, a); GSYNC();
    run_gemm<0>(c, HN, (const bf16_t*)(ws + WS_WO), 1024, 1024, Yb); GSYNC();
    normpass<true, 1, 2, 1, false>(c, XB, Yb, M1 + 2048, 6144, ng + 4096 + 1024, XB, HN, ng + 4096 + 2048, M1 + 3072, M1 + 4096, 6144, nullptr, nullptr, nullptr, nullptr, 0, nullptr, nullptr, nullptr);
    GSYNC();
    run_gemm<2>(c, HN, (const bf16_t*)(ws + WS_W1B), DFF, 1024, H1); GSYNC();
    run_gemm<0>(c, H1, (const bf16_t*)(ws + WS_W2B), 1024, DFF, Yb); GSYNC();
    normpass<true, 1, 1, 0, false>(c, XB, Yb, M1 + 5120, 6144, ng + 4096 + 3072, X, nullptr, nullptr, nullptr, nullptr, 0, nullptr, nullptr, nullptr, nullptr, 0, nullptr, nullptr, nullptr);
#undef c
}
}

extern "C" void kernel_launch(void* const* d_in, const int* in_sizes, int n_in, void* d_out, int out_size, void* d_ws, size_t ws_size, hipStream_t stream) {
    static int grid = 0;
    if (grid == 0) {
        if (n_in != 22 || out_size != mk::M * mk::DM || ws_size < mk::WS_END) { fprintf(stderr, "kernel_launch: unexpected shapes (n_in %d out %d ws %zu)\n", n_in, out_size, ws_size); grid = -1; return; }
        int dev = 0, cus = 0, per_cu = 0;
        hipGetDevice(&dev); hipDeviceGetAttribute(&cus, hipDeviceAttributeMultiprocessorCount, dev);
        hipFuncSetAttribute((const void*)mk::yoco_fwd, hipFuncAttributeMaxDynamicSharedMemorySize, mk::LDS_BYTES);
        hipOccupancyMaxActiveBlocksPerMultiprocessor(&per_cu, (const void*)mk::yoco_fwd, 512, mk::LDS_BYTES);
        if (per_cu < 1) per_cu = 1;
        grid = cus * 1;
        (void)hipGetLastError();
    }
    if (grid < 0) return;
    mk::Args a{};
    for (int i = 0; i < 22; ++i) a.in[i] = (const float*)d_in[i];
    a.out = (float*)d_out; a.ws = (unsigned char*)d_ws;
    void* args[] = {&a};
    if (hipMemsetAsync(d_ws, 0, 65536, stream) != hipSuccess) { fprintf(stderr, "kernel_launch: memset of the barrier words failed\n"); return; }
    hipError_t e = hipLaunchCooperativeKernel((const void*)mk::yoco_fwd, dim3(grid), dim3(512), args, mk::LDS_BYTES, stream);
    if (e != hipSuccess) fprintf(stderr, "cooperative launch failed: %s (grid %d)\n", hipGetErrorString(e), grid);
}
```
